# Optimizing an MI355X kernel written in HIP

```python
import math
import jax, jax.numpy as jnp
from jax import lax
import numpy as np


D_MODEL = 2048
BATCH = 1
SEQ = 16384
DEPTH = 2

D_MIX = D_MODEL
C_POOL = D_MIX // 4
POOL_WINDOWS = (2, 4, 8, 16)
POOL_GROUP = C_POOL // len(POOL_WINDOWS)
C_CONV = D_MIX // 4
CONV_K = 31
FOX_HEADS = 4
FOX_HEAD_DIM = D_MIX // 4 // FOX_HEADS
FOX_DIM = FOX_HEADS * FOX_HEAD_DIM
C_SC = D_MIX - C_POOL - C_CONV - FOX_DIM
SC_K = 3
Q_BLOCK = 128
P_IN = C_POOL + 2 * C_CONV + 3 * FOX_DIM + FOX_HEADS + 3 * C_SC
N_MEM = 256
XA_HEADS = 4
XA_HEAD_DIM = 128
XA_DIM = XA_HEADS * XA_HEAD_DIM
D_FF = ((8 * D_MODEL // 3 + 255) // 256) * 256
EPS = 1e-6
FORGET_BIAS_INIT = 2.0

kernel_name = "hymba_style_pool_conformer_fox_shortconv_macaron"


def _split(z, sizes):
    offs = []
    acc = 0
    for s in sizes[:-1]:
        acc += s
        offs.append(acc)
    return jnp.split(z, offs, axis=-1)


def rmsnorm(x, g):
    xf = x.astype(jnp.float32)
    y = xf * lax.rsqrt(jnp.mean(xf * xf, axis=-1, keepdims=True) + EPS)
    return (y * g.astype(jnp.float32)).astype(x.dtype)


def layernorm(x, g, b):
    xf = x.astype(jnp.float32)
    mu = jnp.mean(xf, axis=-1, keepdims=True)
    xc = xf - mu
    var = jnp.mean(xc * xc, axis=-1, keepdims=True)
    y = xc * lax.rsqrt(var + EPS) * g.astype(jnp.float32) + b.astype(jnp.float32)
    return y.astype(x.dtype)


def swiglu_ffn(h, w_gate, w_up, w_down):
    return (jax.nn.silu(h @ w_gate) * (h @ w_up)) @ w_down


def causal_depthwise_conv(u, w):
    K, C = w.shape
    return lax.conv_general_dilated(
        u, w[:, None, :], window_strides=(1,), padding=((K - 1, 0),),
        dimension_numbers=('NWC', 'WIO', 'NWC'), feature_group_count=C)


def pool_mixer(u, pool_w, pool_scale):
    B, S, C = u.shape
    uf = u.astype(jnp.float32)
    cs0 = jnp.concatenate([jnp.zeros((B, 1, C), jnp.float32), jnp.cumsum(uf, axis=1)], axis=1)
    outs = []
    for g, w in enumerate(POOL_WINDOWS):
        sl = slice(g * POOL_GROUP, (g + 1) * POOL_GROUP)
        c0 = cs0[:, :, sl]
        start = jnp.concatenate([jnp.zeros((B, w - 1, POOL_GROUP), jnp.float32), c0[:, :S - w + 1]], axis=1)
        count = jnp.minimum(jnp.arange(1, S + 1, dtype=jnp.float32), float(w))[None, :, None]
        outs.append((c0[:, 1:] - start) / count - uf[:, :, sl])
    p = jnp.stack(outs, axis=2).astype(u.dtype)
    y = jnp.einsum('bsgc,gcd->bsgd', p, pool_w).reshape(B, S, C)
    return y * pool_scale


def conformer_conv(a, gate, dw_w, dw_b, ln_g, ln_b, pw):
    u = a * jax.nn.sigmoid(gate)
    u = causal_depthwise_conv(u, dw_w) + dw_b
    u = jax.nn.silu(layernorm(u, ln_g, ln_b))
    return u @ pw


def forgetting_attention(q, k, v, f_logit, f_bias):
    B, S, _ = q.shape
    q = q.reshape(B, S, FOX_HEADS, FOX_HEAD_DIM)
    k = k.reshape(B, S, FOX_HEADS, FOX_HEAD_DIM)
    v = v.reshape(B, S, FOX_HEADS, FOX_HEAD_DIM)
    log_f = jax.nn.log_sigmoid((f_logit + f_bias).astype(jnp.float32))
    c = jnp.transpose(jnp.cumsum(log_f, axis=1), (0, 2, 1))
    scale = FOX_HEAD_DIM ** -0.5
    kpos = jnp.arange(S)

    def one_block(i):
        start = i * Q_BLOCK
        qb = lax.dynamic_slice_in_dim(q, start, Q_BLOCK, axis=1)
        cb = lax.dynamic_slice_in_dim(c, start, Q_BLOCK, axis=2)
        s = jnp.einsum('bqhd,bkhd->bhqk', qb, k).astype(jnp.float32) * scale
        s = s + (cb[..., :, None] - c[..., None, :])
        qpos = start + jnp.arange(Q_BLOCK)
        s = jnp.where(kpos[None, :] <= qpos[:, None], s, -jnp.inf)
        p = jax.nn.softmax(s, axis=-1).astype(v.dtype)
        return jnp.einsum('bhqk,bkhd->bqhd', p, v)

    o = lax.map(one_block, jnp.arange(S // Q_BLOCK))
    return jnp.transpose(o, (1, 0, 2, 3, 4)).reshape(B, S, FOX_DIM)


def short_gated_conv(bg, cg, xin, w):
    return bg * causal_depthwise_conv(cg * xin, w)


def memory_cross_attention(h, mem_n, w_q, w_k, w_v, w_o):
    B, S, _ = h.shape
    M = mem_n.shape[1]
    q = (h @ w_q).reshape(B, S, XA_HEADS, XA_HEAD_DIM)
    k = (mem_n @ w_k).reshape(B, M, XA_HEADS, XA_HEAD_DIM)
    v = (mem_n @ w_v).reshape(B, M, XA_HEADS, XA_HEAD_DIM)
    s = jnp.einsum('bqhd,bkhd->bhqk', q, k).astype(jnp.float32) * (XA_HEAD_DIM ** -0.5)
    p = jax.nn.softmax(s, axis=-1).astype(v.dtype)
    o = jnp.einsum('bhqk,bkhd->bqhd', p, v).reshape(B, S, XA_DIM)
    return o @ w_o


def setup_inputs(seed: int = 0) -> dict:
    key = jax.random.key(seed)
    ks = iter(jax.random.split(key, 48))
    L = DEPTH

    def nrm(shape, scale):
        return jax.random.normal(next(ks), shape, jnp.float32) * scale

    def gain(shape):
        return 1.0 + nrm(shape, 0.02)

    return {
        "x": nrm((BATCH, SEQ, D_MODEL), 1.0),
        "mem": nrm((BATCH, N_MEM, D_MODEL), 1.0),
        "ffn1_norm": gain((L, D_MODEL)),
        "ffn1_w_gate": nrm((L, D_MODEL, D_FF), D_MODEL ** -0.5),
        "ffn1_w_up": nrm((L, D_MODEL, D_FF), D_MODEL ** -0.5),
        "ffn1_w_down": nrm((L, D_FF, D_MODEL), D_FF ** -0.5),
        "mix_norm": gain((L, D_MODEL)),
        "w_mix_in": nrm((L, D_MODEL, P_IN), D_MODEL ** -0.5),
        "pool_w": nrm((L, len(POOL_WINDOWS), POOL_GROUP, POOL_GROUP), POOL_GROUP ** -0.5),
        "pool_scale": gain((L, C_POOL)),
        "conv_dw_w": nrm((L, CONV_K, C_CONV), CONV_K ** -0.5),
        "conv_dw_b": nrm((L, C_CONV), 0.02),
        "conv_ln_g": gain((L, C_CONV)),
        "conv_ln_b": nrm((L, C_CONV), 0.02),
        "conv_pw": nrm((L, C_CONV, C_CONV), C_CONV ** -0.5),
        "fox_f_bias": FORGET_BIAS_INIT + nrm((L, FOX_HEADS), 0.5),
        "sc_w": nrm((L, SC_K, C_SC), SC_K ** -0.5),
        "grp_norm": gain((L, D_MIX)),
        "w_mix_out": nrm((L, D_MIX, D_MODEL), D_MIX ** -0.5),
        "xa_norm": gain((L, D_MODEL)),
        "mem_norm": gain((L, D_MODEL)),
        "w_xq": nrm((L, D_MODEL, XA_DIM), D_MODEL ** -0.5),
        "w_xk": nrm((L, D_MODEL, XA_DIM), D_MODEL ** -0.5),
        "w_xv": nrm((L, D_MODEL, XA_DIM), D_MODEL ** -0.5),
        "w_xo": nrm((L, XA_DIM, D_MODEL), XA_DIM ** -0.5),
        "ffn2_norm": gain((L, D_MODEL)),
        "ffn2_w_gate": nrm((L, D_MODEL, D_FF), D_MODEL ** -0.5),
        "ffn2_w_up": nrm((L, D_MODEL, D_FF), D_MODEL ** -0.5),
        "ffn2_w_down": nrm((L, D_FF, D_MODEL), D_FF ** -0.5),
        "final_norm": gain((D_MODEL,)),
    }


def reference(x, mem, ffn1_norm, ffn1_w_gate, ffn1_w_up, ffn1_w_down, mix_norm, w_mix_in,
              pool_w, pool_scale, conv_dw_w, conv_dw_b, conv_ln_g, conv_ln_b, conv_pw,
              fox_f_bias, sc_w, grp_norm, w_mix_out, xa_norm, mem_norm, w_xq, w_xk, w_xv, w_xo,
              ffn2_norm, ffn2_w_gate, ffn2_w_up, ffn2_w_down, final_norm):
    in_sizes = (C_POOL, C_CONV, C_CONV, FOX_DIM, FOX_DIM, FOX_DIM, FOX_HEADS, C_SC, C_SC, C_SC)
    out_sizes = (C_POOL, C_CONV, FOX_DIM, C_SC)
    for l in range(DEPTH):
        h = rmsnorm(x, ffn1_norm[l])
        x = x + 0.5 * swiglu_ffn(h, ffn1_w_gate[l], ffn1_w_up[l], ffn1_w_down[l])

        h = rmsnorm(x, mix_norm[l])
        z = h @ w_mix_in[l]
        (u_pool, glu_a, glu_g, q, k, v, f_logit, sc_b, sc_c, sc_x) = _split(z, in_sizes)
        y_a = pool_mixer(u_pool, pool_w[l], pool_scale[l])
        y_b = conformer_conv(glu_a, glu_g, conv_dw_w[l], conv_dw_b[l], conv_ln_g[l], conv_ln_b[l], conv_pw[l])
        y_c = forgetting_attention(q, k, v, f_logit, fox_f_bias[l])
        y_d = short_gated_conv(sc_b, sc_c, sc_x, sc_w[l])
        g_a, g_b, g_c, g_d = _split(grp_norm[l], out_sizes)
        y = jnp.concatenate([rmsnorm(y_a, g_a), rmsnorm(y_b, g_b), rmsnorm(y_c, g_c), rmsnorm(y_d, g_d)], axis=-1)
        x = x + y @ w_mix_out[l]

        h = rmsnorm(x, xa_norm[l])
        mem_n = rmsnorm(mem, mem_norm[l])
        x = x + memory_cross_attention(h, mem_n, w_xq[l], w_xk[l], w_xv[l], w_xo[l])

        h = rmsnorm(x, ffn2_norm[l])
        x = x + 0.5 * swiglu_ffn(h, ffn2_w_gate[l], ffn2_w_up[l], ffn2_w_down[l])
    return rmsnorm(x, final_norm)
```

```cpp
#define MK_PER_PHASE 0
#include <hip/hip_runtime.h>
#include <hip/hip_cooperative_groups.h>
#include <cstdio>
#include <cstdint>
namespace cg = cooperative_groups;
#define LAS __attribute__((address_space(3)))
typedef short bf16x8 __attribute__((ext_vector_type(8)));
typedef short s16x4 __attribute__((ext_vector_type(4)));
typedef float f32x4 __attribute__((ext_vector_type(4)));
typedef float f32x16 __attribute__((ext_vector_type(16)));
typedef unsigned u32x4 __attribute__((ext_vector_type(4)));
__device__ __forceinline__ int opaque_tid() { int t = threadIdx.x; asm volatile("" : "+v"(t)); return t; }
namespace pg8 {
#define PG8_LAS __attribute__((address_space(3)))
typedef unsigned short bf16_t;
typedef short bf16x8 __attribute__((ext_vector_type(8)));
typedef float f32x4 __attribute__((ext_vector_type(4)));
typedef unsigned u32x4 __attribute__((ext_vector_type(4)));
constexpr int BM = 256, BK = 64, HALF = 128, HTB = HALF * BK * 2  , STAGE_BYTES = 8 * HTB, NXCD = 8, WGM = 8;

__host__ __device__ __forceinline__ int lds_byte(int r, int c) { const int st = (r >> 4) * 2 + (c >> 5), rr = r & 15, cc = c & 31, ob = rr * 64 + cc * 2; return st * 1024 + (ob ^ (((ob >> 9) & 1) << 5)); }
__host__ __device__ __forceinline__ void stage_rc(int b, int& R, int& C) { const int st = b / 1024, sb = b % 1024, swz = sb ^ (((sb >> 9) & 1) << 5); R = (st >> 1) * 16 + swz / 64; C = (st & 1) * 32 + (swz % 64) / 2; }
__host__ __device__ __forceinline__ int perm32(int rho) { const int n = rho >> 4, i = rho & 15; return 8 * (i >> 2) + 4 * n + (i & 3); }

struct Unit { int pm, pn; };
struct Gemm { const bf16_t* A; const bf16_t* Bt; int M, N, K; int ld; };

struct StaticOrder {
    int nM, nN, nwg, G, c;
    __host__ __device__ void init(int M, int N, int G_, int c_) { nM = M / BM; nN = N / BM; nwg = nM * nN; G = G_; c = c_; }
    __host__ __device__ bool next(int i, Unit& u) const {
        const long L = (long)i * G + c; if (L >= nwg) return false;
        int wgid = (int)L; { const int q = nwg / NXCD, r = nwg % NXCD, xcd = wgid % NXCD, off = wgid / NXCD; wgid = (xcd < r ? xcd * (q + 1) : r * (q + 1) + (xcd - r) * q) + off; }
        const int nig = WGM * nN, gid = wgid / nig, fm = gid * WGM, gsz = (nM - fm) < WGM ? (nM - fm) : WGM;
        u.pm = fm + ((wgid % nig) % gsz); u.pn = (wgid % nig) / gsz; return true;
    }
    __device__ __forceinline__ void a_ready(const Unit&) const {}
    __device__ __forceinline__ void done(const Unit&) const {}
};

__device__ __forceinline__ unsigned cvt_pk_bf16(float lo, float hi) { unsigned r; asm volatile("v_cvt_pk_bf16_f32 %0, %1, %2" : "=v"(r) : "v"(lo), "v"(hi)); return r; }

__device__ __forceinline__ float silu_f(float g) { return g * __builtin_amdgcn_rcpf(1.0f + __builtin_amdgcn_exp2f(-1.4426950408889634f * g)); }

__device__ __forceinline__ void rstd_to_lds(const float* RSP, PG8_LAS float* rsl, int pm) {
    const int t = opaque_tid(), row = t >> 1, half = t & 1;
    const f32x4* p = (const f32x4*)(RSP + ((size_t)(pm * BM + row)) * 32 + half * 16);
    const f32x4 a = p[0], b = p[1], c = p[2], d = p[3];
    float s = ((a[0] + a[1]) + (a[2] + a[3])) + ((b[0] + b[1]) + (b[2] + b[3])) + ((c[0] + c[1]) + (c[2] + c[3])) + ((d[0] + d[1]) + (d[2] + d[3]));
    s += __shfl_xor(s, 1);
    if (half == 0) rsl[row] = 1.0f / sqrtf(s * (1.0f / 2048.0f) + 1e-6f);
    asm volatile("s_waitcnt lgkmcnt(0)" ::: "memory"); __builtin_amdgcn_s_barrier(); asm volatile("" ::: "memory");
}
struct EpiSwiGLU {
    static constexpr bool PERM = true, AFTER_DRAIN = false, KSEG = false;
    bf16_t* O; int ldc; const float* RSP; PG8_LAS float* rsl;
    mutable int last_pm = -1;
    __device__ __forceinline__ void operator()(const f32x4 (&acc)[2][2][4][2], const Unit& u, int wr, int wc, int fr, int fq) const {
        if (u.pm != last_pm) { rstd_to_lds(RSP, rsl, u.pm); last_pm = u.pm; }
        const int row0 = u.pm * BM + wr * 64 + fr, col0 = u.pn * HALF + wc * 32 + 8 * fq;
#pragma unroll
        for (int ai = 0; ai < 2; ++ai)
#pragma unroll
            for (int m = 0; m < 4; ++m) { const int row = row0 + ai * HALF + m * 16; bf16_t* rowp = O + (size_t)row * ldc + col0;
                const float rs = rsl[wr * 64 + fr + ai * HALF + m * 16];
                const f32x4 g0 = acc[ai][0][m][0] * rs, g1 = acc[ai][0][m][1] * rs, u0 = acc[ai][1][m][0] * rs, u1 = acc[ai][1][m][1] * rs;
                u32x4 w;
                w.x = cvt_pk_bf16(silu_f(g0[0]) * u0[0], silu_f(g0[1]) * u0[1]); w.y = cvt_pk_bf16(silu_f(g0[2]) * u0[2], silu_f(g0[3]) * u0[3]);
                w.z = cvt_pk_bf16(silu_f(g1[0]) * u1[0], silu_f(g1[1]) * u1[1]); w.w = cvt_pk_bf16(silu_f(g1[2]) * u1[2], silu_f(g1[3]) * u1[3]);
                *(u32x4*)rowp = w; }
    }
};
template <bool FLG> struct EpiResid {
    static constexpr bool PERM = true, AFTER_DRAIN = false, KSEG = FLG;
    bf16_t* XH; float* RSP; float alpha; int pad_;
    const float* GSP = nullptr; PG8_LAS float* gtab = nullptr; mutable int last_pm = -1;
    __device__ __forceinline__ void prep(const Unit& u) const {
        if (u.pm == last_pm) return;
        last_pm = u.pm;
        const int t = opaque_tid();
        if (t < 256) { const f32x4* p = (const f32x4*)(GSP + (size_t)(u.pm * BM + t) * 24);
            const f32x4 a0 = p[0], a1 = p[1], b0 = p[2], b1 = p[3], c0 = p[4];
            const float sa = ((a0[0] + a0[1]) + (a0[2] + a0[3])) + ((a1[0] + a1[1]) + (a1[2] + a1[3])), sb = ((b0[0] + b0[1]) + (b0[2] + b0[3])) + ((b1[0] + b1[1]) + (b1[2] + b1[3])), sc = (c0[0] + c0[1]) + (c0[2] + c0[3]);
            const float r0 = 1.0f / sqrtf(sa * (1.0f / 512.0f) + 1e-6f), r1 = 1.0f / sqrtf(sb * (1.0f / 512.0f) + 1e-6f), r2 = 1.0f / sqrtf(sc * (1.0f / 512.0f) + 1e-6f);
            gtab[t] = r0 / r1; gtab[256 + t] = r1 / r2; gtab[512 + t] = r2; }
        asm volatile("s_waitcnt lgkmcnt(0)" ::: "memory"); __builtin_amdgcn_s_barrier(); asm volatile("" ::: "memory");
    }
    __device__ __forceinline__ void rescale(f32x4 (&acc)[2][2][4][2], int seg, int wr, int fr) const {
#pragma unroll
        for (int ai = 0; ai < 2; ++ai)
#pragma unroll
            for (int m = 0; m < 4; ++m) { const float rho = gtab[(seg - 1) * 256 + wr * 64 + fr + ai * HALF + m * 16];
#pragma unroll
                for (int bj = 0; bj < 2; ++bj)
#pragma unroll
                    for (int n = 0; n < 2; ++n) acc[ai][bj][m][n] = acc[ai][bj][m][n] * rho; }
    }
    __device__ __forceinline__ void operator()(const f32x4 (&acc)[2][2][4][2], const Unit& u, int wr, int wc, int fr, int fq) const {
        const int row0 = u.pm * BM + wr * 64 + fr, col0 = u.pn * BM + wc * 32 + 8 * fq;
#pragma unroll
        for (int ai = 0; ai < 2; ++ai)
#pragma unroll
            for (int mh = 0; mh < 2; ++mh) {
                u32x4 h[2][2];
#pragma unroll
                for (int m2 = 0; m2 < 2; ++m2)
#pragma unroll
                    for (int bj = 0; bj < 2; ++bj) { const size_t off = (size_t)(row0 + ai * HALF + (mh * 2 + m2) * 16) * 2048 + col0 + bj * HALF;
                        h[m2][bj] = *(const u32x4*)(XH + off); }
                __builtin_amdgcn_sched_barrier(0);
#pragma unroll
                for (int m2 = 0; m2 < 2; ++m2) { const int m = mh * 2 + m2, row = row0 + ai * HALF + m * 16;
                    float ss = 0.f;
#pragma unroll
                    for (int bj = 0; bj < 2; ++bj) { const size_t off = (size_t)row * 2048 + col0 + bj * HALF; u32x4 nh;
#pragma unroll
                        for (int w = 0; w < 4; ++w) { const unsigned hw = h[m2][bj][w];
                            const float a0 = acc[ai][bj][m][w >> 1][(w & 1) * 2], a1 = acc[ai][bj][m][w >> 1][(w & 1) * 2 + 1];
                            const float v0 = __uint_as_float(hw << 16) + a0 * alpha, v1 = __uint_as_float(hw & 0xffff0000u) + a1 * alpha;
                            const unsigned ph = cvt_pk_bf16(v0, v1);
                            nh[w] = ph;
                            ss += v0 * v0 + v1 * v1; }
                        *(u32x4*)(XH + off) = nh; }
                    ss += __shfl_xor(ss, 16); ss += __shfl_xor(ss, 32);
                    if (fq == 0) RSP[(size_t)row * 32 + u.pn * 4 + wc] = ss; }
                __builtin_amdgcn_sched_barrier(0);
            }
    }
};
template <int MODE> struct EpiBf {
    static constexpr bool PERM = true, AFTER_DRAIN = false, KSEG = false;
    bf16_t* O; int ldc; const float* RSP; PG8_LAS float* rsl;
    mutable int last_pm = -1;
    float* FLp; int fl_tile; float* GSP = nullptr; int mixmode = 0;
    __device__ __forceinline__ void operator()(const f32x4 (&acc)[2][2][4][2], const Unit& u, int wr, int wc, int fr, int fq) const {
        if (MODE == 0 && RSP && u.pm != last_pm) { rstd_to_lds(RSP, rsl, u.pm); last_pm = u.pm; }
        if (MODE == 0 && FLp && u.pn == fl_tile) {
            if (wc == 0 && fq == 0) {
#pragma unroll
                for (int ai = 0; ai < 2; ++ai)
#pragma unroll
                    for (int m = 0; m < 4; ++m) { const int row = u.pm * BM + wr * 64 + fr + ai * HALF + m * 16;
                        const float rs = rsl[wr * 64 + fr + ai * HALF + m * 16];
                        *(f32x4*)(FLp + (size_t)row * 4) = acc[ai][0][m][0] * rs; } }
            return; }
        if (MODE == 0 && mixmode && ((u.pn >= 2 && u.pn < 6) || (u.pn >= 14 && u.pn < 18))) {
            const bool glu = u.pn < 6; const int ocol = (glu ? 512 + 128 * (u.pn - 2) : 3584 + 128 * (u.pn - 14)) + wc * 32 + 8 * fq;
#pragma unroll
            for (int ai = 0; ai < 2; ++ai)
#pragma unroll
                for (int m = 0; m < 4; ++m) { const int row = u.pm * BM + wr * 64 + fr + ai * HALF + m * 16; const float rs = rsl[wr * 64 + fr + ai * HALF + m * 16];
                    const f32x4 a0 = acc[ai][0][m][0] * rs, a1 = acc[ai][0][m][1] * rs; f32x4 g0 = acc[ai][1][m][0] * rs, g1 = acc[ai][1][m][1] * rs;
                    if (glu) {
#pragma unroll
                        for (int e = 0; e < 4; ++e) { g0[e] = __builtin_amdgcn_rcpf(1.0f + __builtin_amdgcn_exp2f(-1.4426950408889634f * g0[e])); g1[e] = __builtin_amdgcn_rcpf(1.0f + __builtin_amdgcn_exp2f(-1.4426950408889634f * g1[e])); } }
                    const f32x4 v0 = a0 * g0, v1 = a1 * g1;
                    u32x4 w; w.x = cvt_pk_bf16(v0[0], v0[1]); w.y = cvt_pk_bf16(v0[2], v0[3]); w.z = cvt_pk_bf16(v1[0], v1[1]); w.w = cvt_pk_bf16(v1[2], v1[3]);
                    *(u32x4*)(O + (size_t)row * ldc + ocol) = w; }
            return; }
        int prow = u.pm, pcol = u.pn * BM;
        if (MODE == 1) { prow = u.pm & 63; pcol = (u.pm >> 6) * 512 + (u.pn & 1) * 256; }
        const int row0 = prow * BM + wr * 64 + fr, col0 = pcol + wc * 32 + 8 * fq;
#pragma unroll
        for (int ai = 0; ai < 2; ++ai)
#pragma unroll
            for (int m = 0; m < 4; ++m) { const int row = row0 + ai * HALF + m * 16; bf16_t* rowp = O + (size_t)row * ldc + col0;
                const float rs = (MODE == 0 && RSP) ? rsl[wr * 64 + fr + ai * HALF + m * 16] : 1.0f;
                float ss = 0.f;
#pragma unroll
                for (int bj = 0; bj < 2; ++bj) { const f32x4 v0 = acc[ai][bj][m][0] * rs, v1 = acc[ai][bj][m][1] * rs;
                    u32x4 w; w.x = cvt_pk_bf16(v0[0], v0[1]); w.y = cvt_pk_bf16(v0[2], v0[3]); w.z = cvt_pk_bf16(v1[0], v1[1]); w.w = cvt_pk_bf16(v1[2], v1[3]);
                    if (MODE == 1) ss += ((v0[0] * v0[0] + v0[1] * v0[1]) + (v0[2] * v0[2] + v0[3] * v0[3])) + ((v1[0] * v1[0] + v1[1] * v1[1]) + (v1[2] * v1[2] + v1[3] * v1[3]));
                    *(u32x4*)(rowp + bj * HALF) = w; }
                if (MODE == 1) { ss += __shfl_xor(ss, 16); ss += __shfl_xor(ss, 32);
                    if (fq == 0) GSP[(size_t)row * 24 + (u.pm >> 6) * 8 + (u.pn & 1) * 4 + wc] = ss; } }
    }
};
struct PPOrder {
    int G, c;
    __device__ __forceinline__ bool next(int i, Unit& u) const { const int L = i * G + c; if (L >= 256) return false; u.pm = L >> 1; u.pn = (L & 1) + ((L >> 7) << 1); return true; }
    __device__ __forceinline__ void a_ready(const Unit&) const {}
    __device__ __forceinline__ void done(const Unit&) const {}
};
template <class Epi, class Sched, bool ALIGN_EPI = false, bool SP2 = false>
__device__ __forceinline__ void gemm_phase(PG8_LAS unsigned char* lds, const Gemm g, const Sched& S, const Epi& E) {
    const int tid = opaque_tid(), wid = __builtin_amdgcn_readfirstlane(tid >> 6), lane = tid & 63, wr = wid >> 2, wc = wid & 3, fr = lane & 15, fq = lane >> 4;
    const int K = g.K, nt = K / BK, LD = g.ld ? g.ld : K;
    unsigned voffA[2], voffB[2];
#pragma unroll
    for (int i = 0; i < 2; ++i) { int R, C; stage_rc(tid * 16 + i * 8192, R, C); const int Rb = Epi::PERM ? ((R & ~31) + perm32(R & 31)) : R;
        voffA[i] = (unsigned)(R * LD + C) * 2u; voffB[i] = (unsigned)(Rb * LD + C) * 2u; }
    const size_t kstep = (size_t)(BK * 2);
    const size_t hstep = (size_t)HALF * LD * 2;
    const size_t tstep = 2 * hstep;
    const unsigned ldsw = (unsigned)wid * 1024u;
    const int aoff = lds_byte(wr * 64 + fr, fq * 8), boff = lds_byte(wc * 32 + fr, fq * 8);
#define PG8_SA(b, h) (((b) * 2 + (h)) * HTB)
#define PG8_SB(b, h) ((4 + (b) * 2 + (h)) * HTB)
#define PG8_STAGE(bufoff, gbase, voff) do { _Pragma("unroll") for (int _i = 0; _i < 2; ++_i) \
        __builtin_amdgcn_global_load_lds((const unsigned*)((const char*)(gbase) + (voff)[_i]), (PG8_LAS unsigned*)(lds + (bufoff) + ldsw + _i * 8192), 16, 0, 0); } while (0)
#define PG8_LDA(dst, b, h) do { _Pragma("unroll") for (int m = 0; m < 4; ++m) _Pragma("unroll") for (int k = 0; k < 2; ++k) dst[m][k] = *(const PG8_LAS bf16x8*)(lds + PG8_SA(b, h) + aoff + m * 2048 + k * 1024); } while (0)
#define PG8_LDB(dst, b, h) do { _Pragma("unroll") for (int n = 0; n < 2; ++n) _Pragma("unroll") for (int k = 0; k < 2; ++k) dst[n][k] = *(const PG8_LAS bf16x8*)(lds + PG8_SB(b, h) + boff + n * 2048 + k * 1024); } while (0)
#define PG8_MMA(ai, bj, At, Bt) do { __builtin_amdgcn_s_setprio(1); _Pragma("unroll") for (int m = 0; m < 4; ++m) _Pragma("unroll") for (int n = 0; n < 2; ++n) _Pragma("unroll") for (int k = 0; k < 2; ++k) \
        acc[ai][bj][m][n] = __builtin_amdgcn_mfma_f32_16x16x32_bf16(Bt[n][k], At[m][k], acc[ai][bj][m][n], 0, 0, 0); __builtin_amdgcn_s_setprio(0); } while (0)
#define PG8_WAIT_V(n) asm volatile("s_waitcnt vmcnt(" #n ")" ::: "memory")
#define PG8_WAIT_L(n) asm volatile("s_waitcnt lgkmcnt(" #n ")" ::: "memory")
#define PG8_BAR __builtin_amdgcn_s_barrier()
#define PG8_SCHED __builtin_amdgcn_sched_barrier(0)
    Unit cur, nxt; int ui = 0;
    if (!S.next(0, cur)) return;
    f32x4 acc[2][2][4][2];
#pragma unroll
    for (int a = 0; a < 2; ++a)
#pragma unroll
        for (int b = 0; b < 2; ++b)
#pragma unroll
            for (int m = 0; m < 4; ++m)
#pragma unroll
                for (int n = 0; n < 2; ++n) acc[a][b][m][n] = (f32x4){0.f, 0.f, 0.f, 0.f};
    bf16x8 At[4][2], B0[2][2], B1[2][2];
    const char* cA = (const char*)g.A + (size_t)cur.pm * tstep; const char* cB = (const char*)g.Bt + (size_t)cur.pn * tstep;
    if constexpr (Epi::KSEG) E.prep(cur);
    S.a_ready(cur);
    if constexpr (SP2) {
        PG8_STAGE(PG8_SB(0, 0), cB, voffB); PG8_STAGE(PG8_SB(0, 1), cB + hstep, voffB); PG8_STAGE(PG8_SA(0, 0), cA, voffA); PG8_STAGE(PG8_SA(0, 1), cA + hstep, voffA);
        if (wr == 1) PG8_BAR;
        PG8_WAIT_V(2); PG8_BAR;
        PG8_STAGE(PG8_SB(1, 0), cB + kstep, voffB); PG8_STAGE(PG8_SA(1, 0), cA + kstep, voffA); PG8_STAGE(PG8_SB(1, 1), cB + hstep + kstep, voffB);
        PG8_WAIT_V(6); PG8_BAR;
    } else {
        PG8_STAGE(PG8_SB(0, 0), cB, voffB); PG8_STAGE(PG8_SA(0, 0), cA, voffA); PG8_STAGE(PG8_SB(0, 1), cB + hstep, voffB); PG8_STAGE(PG8_SA(0, 1), cA + hstep, voffA);
        if (wr == 1) PG8_BAR;
        PG8_WAIT_V(4); PG8_BAR;
        PG8_STAGE(PG8_SB(1, 0), cB + kstep, voffB); PG8_STAGE(PG8_SA(1, 0), cA + kstep, voffA); PG8_STAGE(PG8_SB(1, 1), cB + hstep + kstep, voffB);
        PG8_WAIT_V(6); PG8_BAR;
    }
    for (;;) {
        const bool has_next = S.next(ui + 1, nxt);
        const char* nA = has_next ? (const char*)g.A + (size_t)nxt.pm * tstep : cA; const char* nB = has_next ? (const char*)g.Bt + (size_t)nxt.pn * tstep : cB;
        for (int t = 0; t < nt; t += 2) {
            if constexpr (Epi::KSEG) { if (t == 8 || t == 16 || t == 24) E.rescale(acc, t >> 3, wr, fr); }
            const bool last = (t == nt - 2);
            const char* a1 = cA + (size_t)(t + 1) * kstep;
            const char* a2 = last ? nA : cA + (size_t)(t + 2) * kstep; const char* b2 = last ? nB : cB + (size_t)(t + 2) * kstep;
            const char* a3 = a2 + kstep; const char* b3 = b2 + kstep;
            if (last && has_next) S.a_ready(nxt);
            if constexpr (SP2) {
            PG8_LDB(B0, 0, 0); PG8_LDB(B1, 0, 1); PG8_SCHED; PG8_LDA(At, 0, 0); PG8_STAGE(PG8_SA(1, 1), a1 + hstep, voffA);
            PG8_WAIT_V(8); PG8_WAIT_L(0); PG8_BAR; PG8_MMA(0, 0, At, B0); PG8_MMA(0, 1, At, B1); PG8_BAR; PG8_SCHED;
            PG8_LDA(At, 0, 1); PG8_STAGE(PG8_SB(0, 0), b2, voffB); PG8_STAGE(PG8_SB(0, 1), b2 + hstep, voffB); PG8_STAGE(PG8_SA(0, 0), a2, voffA);
            PG8_WAIT_V(8); PG8_WAIT_L(0); PG8_BAR; PG8_MMA(1, 0, At, B0); PG8_MMA(1, 1, At, B1); PG8_BAR; PG8_SCHED;
            PG8_LDB(B0, 1, 0); PG8_LDB(B1, 1, 1); PG8_SCHED; PG8_LDA(At, 1, 0); PG8_STAGE(PG8_SA(0, 1), a2 + hstep, voffA);
            PG8_WAIT_V(8); PG8_WAIT_L(0); PG8_BAR; PG8_MMA(0, 0, At, B0); PG8_MMA(0, 1, At, B1); PG8_BAR; PG8_SCHED;
            PG8_LDA(At, 1, 1); PG8_STAGE(PG8_SB(1, 0), b3, voffB); PG8_STAGE(PG8_SB(1, 1), b3 + hstep, voffB); PG8_STAGE(PG8_SA(1, 0), a3, voffA);
            PG8_WAIT_V(8); PG8_WAIT_L(0); PG8_BAR; PG8_MMA(1, 0, At, B0); PG8_MMA(1, 1, At, B1); PG8_BAR; PG8_SCHED;
            } else {
            PG8_LDB(B0, 0, 0); PG8_SCHED; PG8_LDA(At, 0, 0); PG8_STAGE(PG8_SA(1, 1), a1 + hstep, voffA);
            PG8_WAIT_L(8); PG8_BAR; PG8_WAIT_L(0); PG8_MMA(0, 0, At, B0); PG8_BAR; PG8_SCHED;
            PG8_LDB(B1, 0, 1); PG8_STAGE(PG8_SB(0, 0), b2, voffB);
            PG8_BAR; PG8_WAIT_L(0); PG8_MMA(0, 1, At, B1); PG8_BAR;
            PG8_LDA(At, 0, 1); PG8_STAGE(PG8_SA(0, 0), a2, voffA);
            PG8_BAR; PG8_WAIT_L(0); PG8_MMA(1, 0, At, B0); PG8_BAR; PG8_SCHED;
            PG8_STAGE(PG8_SB(0, 1), b2 + hstep, voffB);
            PG8_WAIT_V(6); PG8_BAR; PG8_MMA(1, 1, At, B1); PG8_BAR;
            PG8_LDB(B0, 1, 0); PG8_SCHED; PG8_LDA(At, 1, 0); PG8_STAGE(PG8_SA(0, 1), a2 + hstep, voffA);
            PG8_WAIT_L(8); PG8_BAR; PG8_WAIT_L(0); PG8_MMA(0, 0, At, B0); PG8_BAR; PG8_SCHED;
            PG8_LDB(B1, 1, 1); PG8_STAGE(PG8_SB(1, 0), b3, voffB);
            PG8_BAR; PG8_WAIT_L(0); PG8_MMA(0, 1, At, B1); PG8_BAR;
            PG8_LDA(At, 1, 1); PG8_STAGE(PG8_SA(1, 0), a3, voffA);
            PG8_BAR; PG8_WAIT_L(0); PG8_MMA(1, 0, At, B0); PG8_BAR; PG8_SCHED;
            PG8_STAGE(PG8_SB(1, 1), b3 + hstep, voffB);
            PG8_WAIT_V(6); PG8_BAR; PG8_MMA(1, 1, At, B1); PG8_BAR;
            }
        }
        if constexpr (ALIGN_EPI) { if (wr == 0) PG8_BAR; }
        if constexpr (!Epi::AFTER_DRAIN) { E(acc, cur, wr, wc, fr, fq); S.done(cur); }
        if (!has_next) break;
#pragma unroll
        for (int a = 0; a < 2; ++a)
#pragma unroll
            for (int b = 0; b < 2; ++b)
#pragma unroll
                for (int m = 0; m < 4; ++m)
#pragma unroll
                    for (int n = 0; n < 2; ++n) acc[a][b][m][n] = (f32x4){0.f, 0.f, 0.f, 0.f};
        cur = nxt; cA = nA; cB = nB; ++ui;
        if constexpr (Epi::KSEG) E.prep(cur);
        if constexpr (ALIGN_EPI) { if (wr == 1) PG8_BAR; }
    }
    PG8_WAIT_V(0);
    if constexpr (!ALIGN_EPI) { if (wr == 0) PG8_BAR; }
    PG8_BAR;
    if constexpr (Epi::AFTER_DRAIN) { E.fused(acc, cur, wr, wc, fr, fq, lds, wid, lane); S.done(cur); }
#undef PG8_SA
#undef PG8_SB
#undef PG8_STAGE
#undef PG8_LDA
#undef PG8_LDB
#undef PG8_MMA
#undef PG8_WAIT_V
#undef PG8_WAIT_L
#undef PG8_BAR
#undef PG8_SCHED
}
}
namespace att {
constexpr int D = 128, NW = 8, QBLK = 32, KVBLK = 64, QB = NW * QBLK;
constexpr int SHM_V = KVBLK * D * 2, SHM_K = KVBLK * D * 2;
constexpr int LDS_ATT = 2 * SHM_V + 2 * SHM_K + NW * 64 * 4;
constexpr int CLDS_OFF = LDS_ATT;
constexpr float SCALE = 0.08838834764831845f;
constexpr float C2 = 1.4426950408889634f * SCALE;
constexpr float THR2 = 8.f * 1.4426950408889634f;
typedef unsigned short bf16;

#define KSWZ(row, colB) ((row) * 256 + ((colB) ^ (((row) & 7) << 4)))
#define SBAR() __builtin_amdgcn_sched_barrier(0)
__device__ __forceinline__ int v_st(int k, int c) { const int kk = (k & ~0xC) | ((k & 4) << 1) | ((k & 8) >> 1); return ((kk >> 3) * 4 + (c >> 5)) * 512 + ((kk & 7) * 32 + (c & 31)) * 2; }
__device__ __forceinline__ int v_rd_base(int lane) { return ((lane & 3) << 3) | (((lane >> 2) & 3) << 6) | (((lane >> 4) & 1) << 5) | (((lane >> 5) & 1) << 8); }
constexpr int v_rd_off(int d0, int ks, int half) { return d0 * 512 + ks * 4096 + half * 2048; }
__device__ __forceinline__ int crow(int r, int hi) { return (r & 3) + 8 * (r >> 2) + 4 * hi; }
__device__ __forceinline__ unsigned cvtpk(float lo, float hi) { unsigned r; asm volatile("v_cvt_pk_bf16_f32 %0, %1, %2" : "=v"(r) : "v"(lo), "v"(hi)); return r; }
__device__ __forceinline__ bf16x8 load8(const bf16* p) { return *reinterpret_cast<const bf16x8*>(p); }
__device__ __forceinline__ void mask_tile(f32x16& p0, f32x16& p1, int dq, unsigned W) {
    const float NEG = -__builtin_inff();
#pragma unroll
    for (int r = 0; r < 16; ++r) {
        const int c = (r & 3) + 8 * (r >> 2);
        if ((unsigned)(dq - c) >= W) p0[r] = NEG;
        if ((unsigned)(dq - c - 32) >= W) p1[r] = NEG;
    }
}
__device__ __forceinline__ void partialSM(f32x16& p0, f32x16& p1, float& m_reg, float& mn, float& alpha, float cq) {
    float pmax = p0[0]; for (int r = 1; r < 16; ++r) pmax = fmaxf(pmax, p0[r]); for (int r = 0; r < 16; ++r) pmax = fmaxf(pmax, p1[r]);
    { auto rr = __builtin_amdgcn_permlane32_swap(__float_as_uint(pmax), __float_as_uint(pmax), false, false);
      pmax = fmaxf(__uint_as_float(rr[0]), __uint_as_float(rr[1])); }
    const float tmax = fmaf(pmax, C2, cq);
    if (__builtin_expect(__all((tmax - m_reg) <= THR2), 1)) { mn = m_reg; alpha = 1.f; }
    else { mn = fmaxf(m_reg, tmax); alpha = __builtin_amdgcn_exp2f(m_reg - mn); m_reg = mn; }
    const float mnL = cq - mn;
    for (int r = 0; r < 16; ++r) p0[r] = fmaf(p0[r], C2, mnL); for (int r = 0; r < 16; ++r) p1[r] = fmaf(p1[r], C2, mnL);
    for (int r = 0; r < 16; ++r) p0[r] = __builtin_amdgcn_exp2f(p0[r]);
}
__device__ __forceinline__ void finishSM(f32x16& p0, f32x16& p1, float alpha, float& l_reg, bf16x8& pa0, bf16x8& pa1, bf16x8& pa2, bf16x8& pa3) {
#pragma unroll
    for (int r = 0; r < 16; ++r) p1[r] = __builtin_amdgcn_exp2f(p1[r]);
    float ps = 0;
#pragma unroll
    for (int r = 0; r < 16; ++r) ps += p0[r];
#pragma unroll
    for (int r = 0; r < 16; ++r) ps += p1[r];
    { auto rr = __builtin_amdgcn_permlane32_swap(__float_as_uint(ps), __float_as_uint(ps), false, false);
      ps = __uint_as_float(rr[0]) + __uint_as_float(rr[1]); }
    l_reg = l_reg * alpha + ps;
#define PK4(P, B_, OUT) do { unsigned a0 = cvtpk(P[B_+0], P[B_+1]), a1 = cvtpk(P[B_+2], P[B_+3]);                          \
        unsigned b0 = cvtpk(P[B_+4], P[B_+5]), b1 = cvtpk(P[B_+6], P[B_+7]);                                             \
        auto r0 = __builtin_amdgcn_permlane32_swap(a0, b0, false, false); auto r1 = __builtin_amdgcn_permlane32_swap(a1, b1, false, false); \
        u32x4 w = {r0[0], r1[0], r0[1], r1[1]}; OUT = *reinterpret_cast<bf16x8*>(&w); } while (0)
    PK4(p0, 0, pa0); PK4(p0, 8, pa1); PK4(p1, 0, pa2); PK4(p1, 8, pa3);
#undef PK4
}
template <int KB, bool FOX>
__device__ __forceinline__ void qkt(f32x16& p0, f32x16& p1, const char* K_lds, int r32, int hi, const bf16x8* qr, const LAS float* nclp) {
    if constexpr (FOX) {
#pragma unroll
        for (int g = 0; g < 4; ++g) { const f32x4 n0 = *(const LAS f32x4*)(nclp + 8 * g), n1 = *(const LAS f32x4*)(nclp + 32 + 8 * g);
#pragma unroll
            for (int e = 0; e < 4; ++e) { p0[4 * g + e] = n0[e]; p1[4 * g + e] = n1[e]; } }
    } else { p0 = f32x16{}; p1 = f32x16{}; }
    const char* kb[4];
#pragma unroll
    for (int dd = 0; dd < 4; ++dd) kb[dd] = K_lds + KB * SHM_K + KSWZ(r32, (dd * 16 + hi * 8) * 2);
#pragma unroll
    for (int d0 = 0; d0 < 8; ++d0) { const char* a = kb[d0 & 3] + (d0 >> 2) * 128;
        bf16x8 b0 = *reinterpret_cast<const bf16x8*>(a);
        bf16x8 b1 = *reinterpret_cast<const bf16x8*>(a + 32 * 256);
        p0 = __builtin_amdgcn_mfma_f32_32x32x16_bf16(b0, qr[d0], p0, 0, 0, 0);
        p1 = __builtin_amdgcn_mfma_f32_32x32x16_bf16(b1, qr[d0], p1, 0, 0, 0); }
}
template <int VB>
__device__ __forceinline__ void pv_tile(f32x16* o, int vb0, bf16x8 pa0, bf16x8 pa1, bf16x8 pa2, bf16x8 pa3) {
#define TRRD(dst, off) asm volatile("ds_read_b64_tr_b16 %0, %1 offset:%2" : "=&v"(dst) : "v"(vb0), "i"(off) : "memory")
#define PV_D0(d0) do { s16x4 l0, l1, l2, l3, h0, h1, h2, h3; constexpr int b_ = VB * SHM_V + v_rd_off(d0, 0, 0); \
        TRRD(l0, b_); TRRD(h0, b_ + 2048); TRRD(l1, b_ + 4096); TRRD(h1, b_ + 6144); TRRD(l2, b_ + 8192); TRRD(h2, b_ + 10240); TRRD(l3, b_ + 12288); TRRD(h3, b_ + 14336); \
        asm volatile("s_waitcnt lgkmcnt(0)" ::: "memory"); SBAR();   \
        o[d0] = __builtin_amdgcn_mfma_f32_32x32x16_bf16(pa0, (bf16x8){l0[0], l0[1], l0[2], l0[3], h0[0], h0[1], h0[2], h0[3]}, o[d0], 0, 0, 0);   \
        o[d0] = __builtin_amdgcn_mfma_f32_32x32x16_bf16(pa1, (bf16x8){l1[0], l1[1], l1[2], l1[3], h1[0], h1[1], h1[2], h1[3]}, o[d0], 0, 0, 0);   \
        o[d0] = __builtin_amdgcn_mfma_f32_32x32x16_bf16(pa2, (bf16x8){l2[0], l2[1], l2[2], l2[3], h2[0], h2[1], h2[2], h2[3]}, o[d0], 0, 0, 0);   \
        o[d0] = __builtin_amdgcn_mfma_f32_32x32x16_bf16(pa3, (bf16x8){l3[0], l3[1], l3[2], l3[3], h3[0], h3[1], h3[2], h3[3]}, o[d0], 0, 0, 0); } while (0)
    PV_D0(0); PV_D0(1); PV_D0(2); PV_D0(3);
#undef PV_D0
#undef TRRD
}

struct BlockRef { const bf16* Q; const bf16* K; const bf16* V; bf16* O; const float* CL; int P0; int jlo; const bf16* Q2; float* GS; };
struct Seam { bf16x8 qr[8]; bf16x8 st_v0, st_v1, st_k0, st_k1; };
#define ROWK(p, k0, rr) ((p) + (size_t)((k0) + (rr)) * LDK + sc)
#define VMW() asm volatile("s_waitcnt vmcnt(0)" ::: "memory")
#define VMWN(n) asm volatile("s_waitcnt vmcnt(%0)" :: "i"(n) : "memory")
#define SLOAD_H(Kp, Vp, k0) do { S.st_v0 = load8(ROWK(Vp, k0, sr)); S.st_v1 = load8(ROWK(Vp, k0, 32 + sr));              \
                         S.st_k0 = load8(ROWK(Kp, k0, sr)); S.st_k1 = load8(ROWK(Kp, k0, 32 + sr)); } while (0)
#define SWRITE_HK(bf) do { *(bf16x8*)(K_lds + (bf) * SHM_K + kws) = S.st_k0; *(bf16x8*)(K_lds + (bf) * SHM_K + kws + 32 * 256) = S.st_k1; } while (0)
#define SWRITE_HV(bf) do { *(bf16x8*)(V_lds + (bf) * SHM_V + vst0) = S.st_v0; *(bf16x8*)(V_lds + (bf) * SHM_V + vst1) = S.st_v1; } while (0)
#define SWRITE_H(bf) do { SWRITE_HV(bf); SWRITE_HK(bf); } while (0)
__device__ __forceinline__ bf16x8 add8(bf16x8 a, bf16x8 b) {
    const u32x4 x = *reinterpret_cast<const u32x4*>(&a), y = *reinterpret_cast<const u32x4*>(&b); u32x4 w;
#pragma unroll
    for (int i = 0; i < 4; ++i) w[i] = cvtpk(__uint_as_float(x[i] << 16) + __uint_as_float(y[i] << 16), __uint_as_float(x[i] & 0xffff0000u) + __uint_as_float(y[i] & 0xffff0000u));
    return *reinterpret_cast<bf16x8*>(&w);
}
template <int LDQ, int LDK, bool QSUM = false>
__device__ __forceinline__ void attn_prime(const BlockRef& cur, char* lds, Seam& S) {
    const int tid = opaque_tid(), wid = __builtin_amdgcn_readfirstlane(tid >> 6), lane = tid & 63, r32 = lane & 31, hi = lane >> 5;
    const int sr = tid >> 4, sc = (tid & 15) * 8, kws = KSWZ(sr, sc * 2); char* K_lds = lds + 2 * SHM_V;
    const int kb0 = cur.jlo * KVBLK;
#pragma unroll
    for (int d0 = 0; d0 < 8; ++d0) { S.qr[d0] = load8(cur.Q + (size_t)(wid * QBLK + r32) * LDQ + d0 * 16 + hi * 8);
        if constexpr (QSUM) S.qr[d0] = add8(S.qr[d0], load8(cur.Q2 + (size_t)(wid * QBLK + r32) * LDQ + d0 * 16 + hi * 8)); }
    SLOAD_H(cur.K, cur.V, kb0); VMW(); SWRITE_HK(0);
    __syncthreads();
}
template <bool FOX, int LDQ, int LDK, int LDO>
__device__ __forceinline__ void attn_block(const BlockRef& cur, const BlockRef& nxt, int skv, unsigned W, char* lds, LAS float* clds, Seam& S) {
    const int tid = opaque_tid(), wid = __builtin_amdgcn_readfirstlane(tid >> 6), lane = tid & 63, r32 = lane & 31, hi = lane >> 5;
    const int j_lo = cur.jlo;
    int j_hi = (cur.P0 + QB - 1) / KVBLK + 1; if (j_hi > skv / KVBLK) j_hi = skv / KVBLK;
    const int NT = j_hi - j_lo;
    const int kbn = nxt.jlo * KVBLK;
    const int qlo = cur.P0 + wid * QBLK, qm = qlo + r32 - 4 * hi;
    char* V_lds = lds; char* K_lds = lds + 2 * SHM_V;
    float* ws = (float*)(lds + 2 * SHM_V + 2 * SHM_K) + wid * 64; float* li_l = ws, * al_l = ws + 32;
    float m_reg = -1e30f, l_reg = 0; f32x16 o[4] = {};
    const int sr = tid >> 4, sc = (tid & 15) * 8, vst0 = v_st(sr, sc), vst1 = v_st(32 + sr, sc), kws = KSWZ(sr, sc * 2);
    const int vb0 = (int)(uintptr_t)V_lds + v_rd_base(lane);
    float cq = 0.f; const LAS float* nclb = clds + 4 * hi;
    if constexpr (FOX) {
        const float cref = cur.CL[cur.P0];
        for (int i = j_lo * KVBLK + tid * 4; i < cur.P0 + QB; i += 2048) { const f32x4 v = *(const f32x4*)(cur.CL + i); *(LAS f32x4*)(clds + i) = (cref - v) * (1.0f / C2); }
        cq = cur.CL[qlo + r32] - cref;
    }
    const bf16* Kh = cur.K; const bf16* Vh = cur.V;
#define RESC(a) do { if (__any((a) < 1.f)) { if (hi == 0) al_l[r32] = (a); asm volatile("s_waitcnt lgkmcnt(0)" ::: "memory");              \
                     for (int d_ = 0; d_ < 4; ++d_) for (int r = 0; r < 16; ++r) o[d_][r] *= al_l[crow(r, hi)]; } } while (0)
#define KBASE(t) ((j_lo + (t)) * KVBLK)
#define MASKT(P0_, P1_, t) do { const int kb_ = KBASE(t); if (kb_ + KVBLK - 1 > qlo || kb_ <= qlo + QBLK - 1 - (int)W) mask_tile(P0_, P1_, qm - kb_, W); } while (0)
    f32x16 pX0, pX1; float mnX, alX; bf16x8 pa0, pa1, pa2, pa3;
    SWRITE_HV(0); SBAR();
    if (NT > 1) { SLOAD_H(Kh, Vh, KBASE(1)); }
    __syncthreads();
#define TILE_STEP(t, B) do {                                                                                      \
        SBAR(); qkt<B, FOX>(pX0, pX1, K_lds, r32, hi, S.qr, nclb + KBASE(t)); SBAR();                             \
        if ((t) + 1 < NT) { VMW(); SWRITE_H((B) ^ 1); SBAR(); if ((t) + 2 < NT) { SLOAD_H(Kh, Vh, KBASE((t) + 2)); } SBAR(); } \
        MASKT(pX0, pX1, (t)); partialSM(pX0, pX1, m_reg, mnX, alX, cq); RESC(alX);                                \
        finishSM(pX0, pX1, alX, l_reg, pa0, pa1, pa2, pa3); SBAR();                                               \
        pv_tile<B>(o, vb0, pa0, pa1, pa2, pa3);                                                                   \
        __syncthreads(); } while (0)
    int t = 0;
    for (; t + 1 < NT; t += 2) { TILE_STEP(t, 0); TILE_STEP(t + 1, 1); }
    if (t < NT) { TILE_STEP(t, 0); }
    SLOAD_H(nxt.K, nxt.V, kbn); SBAR();
#pragma unroll
    for (int d0 = 0; d0 < 8; ++d0) S.qr[d0] = load8(nxt.Q + (size_t)(wid * QBLK + r32) * LDQ + d0 * 16 + hi * 8);
    SBAR();
    if (hi == 0) li_l[r32] = l_reg; asm volatile("s_waitcnt lgkmcnt(0)" ::: "memory");
    float rli[16];
#pragma unroll
    for (int r = 0; r < 16; ++r) rli[r] = __builtin_amdgcn_rcpf(li_l[crow(r, hi)]);
    VMWN(8); SWRITE_HK(0); SBAR();
    bf16* Ow = cur.O + (size_t)(wid * QBLK) * LDO;
#pragma unroll
    for (int r = 0; r < 16; ++r) { const int orow = crow(r, hi);
        float sq = 0.f;
#pragma unroll
        for (int d0 = 0; d0 < 4; ++d0) { const float v = o[d0][r] * rli[r];
            const float vn = __shfl_xor(v, 1);
            sq += v * v;
            if ((r32 & 1) == 0) *(unsigned*)(Ow + (size_t)orow * LDO + d0 * 32 + r32) = cvtpk(v, vn); }
        if constexpr (FOX) {
            sq += __shfl_xor(sq, 1); sq += __shfl_xor(sq, 2); sq += __shfl_xor(sq, 4); sq += __shfl_xor(sq, 8); sq += __shfl_xor(sq, 16);
            if (r32 == 0) cur.GS[(size_t)(wid * QBLK + orow) * 24] = sq; } }
    __syncthreads();
#undef RESC
#undef KBASE
#undef MASKT
#undef TILE_STEP
}
#undef ROWK
#undef VMW
#undef VMWN
#undef SLOAD_H
#undef SWRITE_HK
#undef SWRITE_HV
#undef SWRITE_H
}
#define XB_TMO      128
#define XB_XCNT(j)  (256  + 64 * (j))
#define XB_XSUB(j)  (1280 + 64 * (j))
#define XB_XGEN(j)  (2304 + 64 * (j))
#define XB_TOP      3328
#define XB_TOPGEN   3392
#define XCD_BAR_WORDS 3456
#define XB_SPIN_CAP (1u << 18)

__device__ __forceinline__ unsigned xb_ld(unsigned* p)              { return __hip_atomic_load(p, __ATOMIC_RELAXED, __HIP_MEMORY_SCOPE_AGENT); }
__device__ __forceinline__ unsigned xb_add(unsigned* p, unsigned v) { return __hip_atomic_fetch_add(p, v, __ATOMIC_RELAXED, __HIP_MEMORY_SCOPE_AGENT); }
__device__ __forceinline__ unsigned xb_xcc_id() { return (unsigned)__builtin_amdgcn_s_getreg((3 << 11) | 20) & 0xFu; }
#define XB_SPIN(cond, bar) do { unsigned _sp = 0; while (cond) { __builtin_amdgcn_s_sleep(1); \
    if ((++_sp & 255u) == 0u) { if (xb_ld(&(bar)[XB_TMO])) break; if (_sp > XB_SPIN_CAP) { atomicAdd(&(bar)[XB_TMO], 1u); break; } } } } while (0)

struct XcdBarrier {
    unsigned* bar; unsigned x;
    volatile LAS unsigned* st;
};

__device__ __forceinline__ XcdBarrier xcd_barrier_post(unsigned* bar, volatile LAS unsigned* st) {
    XcdBarrier b; b.bar = bar; b.x = xb_xcc_id(); b.st = st;
    if (threadIdx.x == 0) (void)xb_add(&bar[XB_XCNT(b.x)], 1u);
    return b;
}
__device__ __forceinline__ void xcd_barrier_complete(unsigned* bar, unsigned x, unsigned& nloc, unsigned& nx) {
    const unsigned G = gridDim.x * gridDim.y * gridDim.z;
    unsigned sum, cnt, mine, sp = 0u;
    for (;;) {
        sum = 0u; cnt = 0u; mine = 0u;
#pragma unroll
        for (unsigned j = 0; j < 16; ++j) { const unsigned c = xb_ld(&bar[XB_XCNT(j)]); sum += c; cnt += (c > 0u) ? 1u : 0u; mine = (j == x) ? c : mine; }
        if (sum == G) break;
        __builtin_amdgcn_s_sleep(1);
        if ((++sp & 255u) == 0u) { if (xb_ld(&bar[XB_TMO])) break; if (sp > XB_SPIN_CAP) { atomicAdd(&bar[XB_TMO], 1u); break; } }
    }
    nloc = mine > 0u ? mine : 1u; nx = cnt > 0u ? cnt : 1u;
}

__device__ __forceinline__ void xcd_barrier(const XcdBarrier& b) {
    asm volatile("s_waitcnt vmcnt(0)" ::: "memory");
    __syncthreads();
    if (threadIdx.x == 0) {
        unsigned* bar = b.bar; asm volatile("" : "+s"(bar)); unsigned bx = b.x; asm volatile("" : "+s"(bx));
        __builtin_amdgcn_s_waitcnt(0);
        unsigned nloc = b.st[0], nx = b.st[1];
        if (nloc == 0u) { xcd_barrier_complete(bar, bx, nloc, nx); b.st[0] = nloc; b.st[1] = nx; }
        const unsigned old = xb_add(&bar[XB_XSUB(bx)], 1u);
        const unsigned gen = old / nloc;
        if (old + 1u == (gen + 1u) * nloc) {
            __builtin_amdgcn_fence(__ATOMIC_RELEASE, "agent");
            asm volatile("s_waitcnt vmcnt(0)" ::: "memory");
            const unsigned og = xb_add(&bar[XB_TOP], 1u);
            const unsigned tg = og / nx;
            if (og + 1u == (tg + 1u) * nx) xb_add(&bar[XB_TOPGEN], 1u);
            else XB_SPIN(xb_ld(&bar[XB_TOPGEN]) == tg, bar);
            __builtin_amdgcn_fence(__ATOMIC_ACQUIRE, "agent");
            xb_add(&bar[XB_XGEN(bx)], 1u);
            asm volatile("s_waitcnt vmcnt(0)" ::: "memory");
        } else {
            XB_SPIN(xb_ld(&bar[XB_XGEN(bx)]) == gen, bar);
            __builtin_amdgcn_fence(__ATOMIC_ACQUIRE, "agent");
            asm volatile("s_waitcnt vmcnt(0)" ::: "memory");
        }
    }
    __syncthreads();
}


#ifndef MK_PER_PHASE
#define MK_PER_PHASE 0
#endif
constexpr int S = 16384, DM = 2048, DFF = 5632, PIN = 4612, NZ = 4608, NZP = 4864, NMEM = 256, NLAYER = 2;
constexpr float EPS = 1e-6f;
constexpr float LOG2E = 1.4426950408889634f;
constexpr size_t MiB = 1u << 20;
constexpr size_t WS_CTL = 0;
constexpr size_t WS_BAR = 64 * 1024;
constexpr size_t WS_WF = 1 * MiB;
constexpr size_t WS_FL = 1 * MiB + 256 * 1024;
constexpr size_t WS_CL = 1 * MiB + 512 * 1024;
constexpr size_t WS_RSA = 680 * MiB, WS_RSB = 684 * MiB;
constexpr size_t WS_MEMN = 3 * MiB;
constexpr size_t WS_KVX = 5 * MiB;
constexpr size_t WS_XB = 6 * MiB;
constexpr size_t WS_HID = 70 * MiB;
constexpr size_t WS_Z = WS_HID, WS_PC = WS_HID + 144 * MiB;
constexpr size_t WS_Y = 246 * MiB;
constexpr size_t WS_QX = 310 * MiB, WS_OX = 326 * MiB;
constexpr size_t WS_GSP = 706 * MiB;
constexpr size_t WS_QX2 = 688 * MiB;
constexpr size_t WS_W = 342 * MiB;
constexpr size_t OW_GU1 = 0, OW_D1 = OW_GU1 + (size_t)2 * DFF * DM, OW_MI = OW_D1 + (size_t)DM * DFF, OW_PP = OW_MI + (size_t)NZP * DM, OW_MO = OW_PP + 1024 * 512,
                 OW_XQ = OW_MO + (size_t)DM * DM, OW_XKV = OW_XQ + 512 * DM, OW_XO = OW_XKV + 1024 * DM, OW_GU2 = OW_XO + DM * 512, OW_D2 = OW_GU2 + (size_t)2 * DFF * DM,
                 LAYER_W = OW_D2 + (size_t)DM * DFF;
constexpr size_t WS_END = WS_W + 2 * LAYER_W * 2;
static_assert(WS_END <= WS_RSA && WS_RSB + 2 * MiB <= 790 * MiB, "ws map");
constexpr size_t WS_NEED = 790 * MiB;
constexpr int LDS_BYTES = 147456;
constexpr int NPH = 1 + 16 * NLAYER;
#ifndef PH_MASK
#define PH_MASK 0x1ffff
#endif
#define PH_EN(k) (((PH_MASK) >> (k)) & 1)

typedef unsigned short bf16;
__device__ __forceinline__ float bf2f(bf16 b) { return __uint_as_float(((unsigned)b) << 16); }
__device__ __forceinline__ unsigned f2bf(float f) { unsigned u = __builtin_bit_cast(unsigned, f); return (u + 0x7fffu + ((u >> 16) & 1u)) >> 16; }
__device__ __forceinline__ unsigned pk2(float lo, float hi) { return f2bf(lo) | (f2bf(hi) << 16); }
#define LDS_WAIT() asm volatile("s_waitcnt lgkmcnt(0)" ::: "memory")
__device__ __forceinline__ float wave_sum(float v) {
#pragma unroll
    for (int o = 1; o < 64; o <<= 1) v += __shfl_xor(v, o);
    return v;
}
__device__ __forceinline__ float sigmoid_f(float g) { return __builtin_amdgcn_rcpf(1.0f + __builtin_amdgcn_exp2f(-LOG2E * g)); }

__device__ __forceinline__ void tr_item(const float* W, int ldw, int src_col0, int k0, bf16* WT, int K, int dst_row0, const float* ksc, LAS float* scr, int lane) {
    f32x4 v[8];
    const int r = lane >> 3, c4 = (lane & 7) * 4;
    const float* wp = W + (size_t)(k0 + r) * ldw + src_col0 + c4;
#pragma unroll
    for (int i = 0; i < 8; ++i) v[i] = *(const f32x4*)(wp + (size_t)(8 * i) * ldw);
    if (ksc) {
        const float* kp = ksc + k0 + r;
#pragma unroll
        for (int i = 0; i < 8; ++i) v[i] = v[i] * kp[8 * i];
    }
#pragma unroll
    for (int i = 0; i < 8; ++i) { LAS float* d = scr + (8 * i + r) * 33 + c4; d[0] = v[i][0]; d[1] = v[i][1]; d[2] = v[i][2]; d[3] = v[i][3]; }
    LDS_WAIT(); asm volatile("" ::: "memory");
    const int c = lane & 7;
#pragma unroll
    for (int j = 0; j < 4; ++j) { const int n = (lane >> 3) + 8 * j; const LAS float* s = scr + (8 * c) * 33 + n;
        u32x4 o; o.x = pk2(s[0 * 33], s[1 * 33]); o.y = pk2(s[2 * 33], s[3 * 33]); o.z = pk2(s[4 * 33], s[5 * 33]); o.w = pk2(s[6 * 33], s[7 * 33]);
        *(u32x4*)(WT + (size_t)(dst_row0 + n) * K + k0 + 8 * c) = o; }
    LDS_WAIT(); asm volatile("" ::: "memory");
}
__device__ __forceinline__ void tr_job(int r, const float* W, int ldw, int K, int Ndst, bf16* WT, int row_off, const float* ksc, int cmode, LAS float* scr, int lane) {
    const int nblk = Ndst / 32, kb = r / nblk, nb = r % nblk, n0 = 32 * nb;
    int src = n0, dst = row_off + n0;
    if (cmode == 1) dst = 256 * (n0 >> 7) + (n0 & 127);
    else if (cmode == 2) dst = 256 * (n0 >> 7) + 128 + (n0 & 127);
    else if (cmode == 3) { src = n0 + (n0 >= 3072 ? 4 : 0);
        if (n0 >= 512 && n0 < 1024) dst = row_off + 512 + 256 * ((n0 - 512) >> 7) + ((n0 - 512) & 127);
        else if (n0 >= 1024 && n0 < 1536) dst = row_off + 512 + 256 * ((n0 - 1024) >> 7) + 128 + ((n0 - 1024) & 127);
        else if (n0 >= 3584 && n0 < 4096) dst = row_off + 3584 + 256 * ((n0 - 3584) >> 7) + ((n0 - 3584) & 127);
        else if (n0 >= 4096 && n0 < 4608) dst = row_off + 3584 + 256 * ((n0 - 4096) >> 7) + 128 + ((n0 - 4096) & 127); }
    tr_item(W, ldw, src, 64 * kb, WT, K, dst, ksc, scr, lane);
}

template <int MODE>
__device__ __forceinline__ void norm_rows(const float* X, bf16* XB, const float* gain, float* OUT, const float* WF, float* FL, int nrows, int gw, int NGW, int lane) {
    f32x4 gv[8];
    if (MODE == 2) {
#pragma unroll
        for (int j = 0; j < 8; ++j) gv[j] = ((const f32x4*)gain + lane)[64 * j];
    }
    for (int row = gw; row < nrows; row += NGW) {
        const f32x4* xr = (const f32x4*)(X + (size_t)row * DM) + lane;
        f32x4 v[8]; float ss = 0.f;
#pragma unroll
        for (int j = 0; j < 8; ++j) v[j] = xr[64 * j];
        __builtin_amdgcn_sched_barrier(0);
#pragma unroll
        for (int j = 0; j < 8; ++j) ss += (v[j].x * v[j].x + v[j].y * v[j].y) + (v[j].z * v[j].z + v[j].w * v[j].w);
        const float sst = wave_sum(ss); const float rstd = MODE == 3 ? 1.0f : 1.0f / sqrtf(sst * (1.0f / DM) + EPS);
        if (MODE == 3 && lane < 32) OUT[(size_t)row * 32 + lane] = lane == 0 ? sst : 0.f;
        if (MODE == 2) {
            f32x4* orow = (f32x4*)(OUT + (size_t)row * DM) + lane;
#pragma unroll
            for (int j = 0; j < 8; ++j) orow[64 * j] = v[j] * rstd * gv[j];
        } else {
            unsigned long long* o8 = (unsigned long long*)(XB + (size_t)row * DM) + lane;
#pragma unroll
            for (int j = 0; j < 8; ++j) o8[64 * j] = (unsigned long long)pk2(v[j].x * rstd, v[j].y * rstd) | ((unsigned long long)pk2(v[j].z * rstd, v[j].w * rstd) << 32);
            if (MODE == 1) {
#pragma unroll
                for (int h = 0; h < 4; ++h) { const f32x4* wr = (const f32x4*)(WF + h * DM) + lane; float d = 0.f;
#pragma unroll
                    for (int j = 0; j < 8; ++j) { const f32x4 w = wr[64 * j]; d += (v[j].x * w.x + v[j].y * w.y) + (v[j].z * w.z + v[j].w * w.w); }
                    d = wave_sum(d); if (lane == 0) FL[row * 4 + h] = d * rstd; }
            }
        }
    }
}
__device__ __forceinline__ void split_rows(const float* X, bf16* XH, float* RSP, int gw, int NGW, int lane) {
    for (int row = gw; row < S; row += NGW) {
        const f32x4* xr = (const f32x4*)(X + (size_t)row * DM) + lane;
        f32x4 v[8]; float ss = 0.f;
#pragma unroll
        for (int j = 0; j < 8; ++j) v[j] = xr[64 * j];
        __builtin_amdgcn_sched_barrier(0);
        unsigned long long* oh = (unsigned long long*)(XH + (size_t)row * DM) + lane;
#pragma unroll
        for (int j = 0; j < 8; ++j) { ss += (v[j].x * v[j].x + v[j].y * v[j].y) + (v[j].z * v[j].z + v[j].w * v[j].w);
            const unsigned h0 = pk2(v[j].x, v[j].y), h1 = pk2(v[j].z, v[j].w);
            oh[64 * j] = (unsigned long long)h0 | ((unsigned long long)h1 << 32); }
        const float sst = wave_sum(ss);
        if (lane < 32) RSP[(size_t)row * 32 + lane] = lane == 0 ? sst : 0.f;
    }
}
__device__ __forceinline__ void final_rows(const bf16* XH, const float* RSP, const float* gain, float* OUT, int gw, int NGW, int lane) {
    f32x4 gv[4][2];
#pragma unroll
    for (int j = 0; j < 4; ++j) { gv[j][0] = *(const f32x4*)(gain + 8 * (lane + 64 * j)); gv[j][1] = *(const f32x4*)(gain + 8 * (lane + 64 * j) + 4); }
    for (int row = gw; row < S; row += NGW) {
        const u32x4* xh = (const u32x4*)(XH + (size_t)row * DM) + lane;
        u32x4 wh[4];
#pragma unroll
        for (int j = 0; j < 4; ++j) wh[j] = xh[64 * j];
        const float p = RSP[(size_t)row * 32 + (lane & 31)];
        __builtin_amdgcn_sched_barrier(0);
        const float rstd = 1.0f / sqrtf(wave_sum(lane < 32 ? p : 0.f) * (1.0f / DM) + EPS);
        float* orow = OUT + (size_t)row * DM;
#pragma unroll
        for (int j = 0; j < 4; ++j) { const u32x4 q = wh[j];
            f32x4 a = {__uint_as_float(q.x << 16), __uint_as_float(q.x & 0xffff0000u), __uint_as_float(q.y << 16), __uint_as_float(q.y & 0xffff0000u)};
            f32x4 b = {__uint_as_float(q.z << 16), __uint_as_float(q.z & 0xffff0000u), __uint_as_float(q.w << 16), __uint_as_float(q.w & 0xffff0000u)};
            *(f32x4*)(orow + 8 * (lane + 64 * j)) = a * rstd * gv[j][0]; *(f32x4*)(orow + 8 * (lane + 64 * j) + 4) = b * rstd * gv[j][1]; }
    }
}
__device__ __forceinline__ void group_norm_rows(bf16* Y, int gw, int NGW, int lane) {
    for (int row = gw; row < S; row += 2 * NGW) {
        u32x4* yr0 = (u32x4*)(Y + (size_t)row * DM) + lane; u32x4* yr1 = (u32x4*)(Y + (size_t)(row + NGW) * DM) + lane;
        u32x4 w[2][3];
#pragma unroll
        for (int g = 0; g < 3; ++g) { w[0][g] = yr0[64 * g]; w[1][g] = yr1[64 * g]; }
        __builtin_amdgcn_sched_barrier(0);
#pragma unroll
        for (int r = 0; r < 2; ++r)
#pragma unroll
            for (int g = 0; g < 3; ++g) { const u32x4 q = w[r][g]; float f[8];
                f[0] = __uint_as_float(q.x << 16); f[1] = __uint_as_float(q.x & 0xffff0000u); f[2] = __uint_as_float(q.y << 16); f[3] = __uint_as_float(q.y & 0xffff0000u);
                f[4] = __uint_as_float(q.z << 16); f[5] = __uint_as_float(q.z & 0xffff0000u); f[6] = __uint_as_float(q.w << 16); f[7] = __uint_as_float(q.w & 0xffff0000u);
                float ss = 0.f;
#pragma unroll
                for (int e = 0; e < 8; ++e) ss += f[e] * f[e];
                const float rstd = 1.0f / sqrtf(wave_sum(ss) * (1.0f / 512.0f) + EPS);
                u32x4 o; o.x = pk2(f[0] * rstd, f[1] * rstd); o.y = pk2(f[2] * rstd, f[3] * rstd); o.z = pk2(f[4] * rstd, f[5] * rstd); o.w = pk2(f[6] * rstd, f[7] * rstd);
                (r ? yr1 : yr0)[64 * g] = o; }
    }
}

template <int PM>
__device__ __forceinline__ void ew_post(LAS float* buf, bf16* dst, int ld, const float* lg, const float* lb, int wid, int lane) {
    f32x4 g0 = {1, 1, 1, 1}, g1 = g0, b0 = {0, 0, 0, 0}, b1 = b0;
    if (PM == 1) { g0 = *(const f32x4*)(lg + 8 * lane); g1 = *(const f32x4*)(lg + 8 * lane + 4); b0 = *(const f32x4*)(lb + 8 * lane); b1 = *(const f32x4*)(lb + 8 * lane + 4); }
#pragma unroll
    for (int q = 0; q < 4; ++q) { const int i = wid * 4 + q;
        f32x4 v0 = *(const LAS f32x4*)(buf + i * 512 + 8 * lane), v1 = *(const LAS f32x4*)(buf + i * 512 + 8 * lane + 4);
        if (PM == 1) {
            const float mean = wave_sum((v0.x + v0.y) + (v0.z + v0.w) + (v1.x + v1.y) + (v1.z + v1.w)) * (1.0f / 512.0f);
            v0 = v0 - mean; v1 = v1 - mean;
            const float var = wave_sum((v0.x * v0.x + v0.y * v0.y) + (v0.z * v0.z + v0.w * v0.w) + (v1.x * v1.x + v1.y * v1.y) + (v1.z * v1.z + v1.w * v1.w)) * (1.0f / 512.0f);
            const float rstd = 1.0f / sqrtf(var + EPS);
            v0 = v0 * rstd * g0 + b0; v1 = v1 * rstd * g1 + b1;
            v0.x *= sigmoid_f(v0.x); v0.y *= sigmoid_f(v0.y); v0.z *= sigmoid_f(v0.z); v0.w *= sigmoid_f(v0.w);
            v1.x *= sigmoid_f(v1.x); v1.y *= sigmoid_f(v1.y); v1.z *= sigmoid_f(v1.z); v1.w *= sigmoid_f(v1.w);
        } else if (PM == 2) {
            const float ss = wave_sum((v0.x * v0.x + v0.y * v0.y) + (v0.z * v0.z + v0.w * v0.w) + (v1.x * v1.x + v1.y * v1.y) + (v1.z * v1.z + v1.w * v1.w)) * (1.0f / 512.0f);
            const float rstd = 1.0f / sqrtf(ss + EPS);
            v0 = v0 * rstd; v1 = v1 * rstd;
        }
        u32x4 o; o.x = pk2(v0.x, v0.y); o.y = pk2(v0.z, v0.w); o.z = pk2(v1.x, v1.y); o.w = pk2(v1.z, v1.w);
        *(u32x4*)(dst + (size_t)i * ld + 8 * lane) = o; }
}
template <int NC, int NIT>
__device__ __forceinline__ void ew_stage(const bf16* Z, int col0, int row_first, int nrows, LAS unsigned char* stg, int tid) {
    constexpr int CPR = NC / 8;
    u32x4 v[NIT];
#pragma unroll
    for (int it = 0; it < NIT; ++it) { int c = tid + it * 512; if (c >= nrows * CPR) c = nrows * CPR - 1; const int r = c / CPR, cc = c % CPR; int tt = row_first + r; tt = tt < 0 ? 0 : tt;
        v[it] = *(const u32x4*)(Z + (size_t)tt * NZ + col0 + cc * 8); }
    __builtin_amdgcn_sched_barrier(0);
#pragma unroll
    for (int it = 0; it < NIT; ++it) { int c = tid + it * 512; if (c >= nrows * CPR) c = nrows * CPR - 1;
        *(LAS u32x4*)(stg + (size_t)c * 16) = v[it]; }
}
__device__ __forceinline__ void ew_chunk(const bf16* Z, bf16* PC, bf16* Y, const float* dw_w, const float* dw_b, const float* ln_g, const float* ln_b, const float* sc_w,
                                         float* NRM, LAS float* buf, int chunk, int tid, int wid, int lane) {
    const int t0 = chunk * 32, ch = tid;
    LAS unsigned char* stg = (LAS unsigned char*)buf + 65536; const LAS bf16* st16 = (const LAS bf16*)stg;
    {
        const int p = tid >> 1, isK = p >> 7, tok = (p >> 2) & 31, hd = p & 3;
        const bf16* src = Z + (size_t)(t0 + tok) * NZ + 1536 + isK * 512 + hd * 128 + (tid & 1) * 64;
        u32x4 w8[8];
#pragma unroll
        for (int c = 0; c < 8; ++c) w8[c] = *(const u32x4*)(src + 8 * c);
        __builtin_amdgcn_sched_barrier(0);
        float ss = 0.f;
#pragma unroll
        for (int c = 0; c < 8; ++c) { const u32x4 w = w8[c];
            const float f0 = __uint_as_float(w.x << 16), f1 = __uint_as_float(w.x & 0xffff0000u), f2 = __uint_as_float(w.y << 16), f3 = __uint_as_float(w.y & 0xffff0000u);
            const float f4 = __uint_as_float(w.z << 16), f5 = __uint_as_float(w.z & 0xffff0000u), f6 = __uint_as_float(w.w << 16), f7 = __uint_as_float(w.w & 0xffff0000u);
            ss += (f0 * f0 + f1 * f1) + (f2 * f2 + f3 * f3) + (f4 * f4 + f5 * f5) + (f6 * f6 + f7 * f7); }
        ss += __shfl_xor(ss, 1);
        ss = fmaxf(ss, __shfl_xor(ss, 8)); ss = fmaxf(ss, __shfl_xor(ss, 16)); ss = fmaxf(ss, __shfl_xor(ss, 32));
        if (lane < 8 && !(lane & 1)) NRM[(isK * 4 + hd) * 2048 + chunk * 4 + (wid & 3)] = ss;
    }
    {
        float seq[62];
        ew_stage<512, 8>(Z, 512, t0 - 30, 62, stg, tid);
        __syncthreads();
#pragma unroll
        for (int i = 0; i < 62; ++i) { const int tt = t0 - 30 + i; seq[i] = (tt < 0 ? 0.f : 1.f) * bf2f(st16[i * 512 + ch]); }
        __syncthreads();
        float cv[32], wk[31]; const float b = dw_b[ch];
#pragma unroll
        for (int k = 0; k < 31; ++k) wk[k] = dw_w[k * 512 + ch];
        __builtin_amdgcn_sched_barrier(0);
#pragma unroll
        for (int i = 0; i < 32; ++i) cv[i] = b;
#pragma unroll
        for (int k = 0; k < 31; ++k) {
#pragma unroll
            for (int i = 0; i < 32; ++i) cv[i] = fmaf(wk[k], seq[i + k], cv[i]); }
#pragma unroll
        for (int i = 0; i < 32; ++i) buf[i * 512 + ch] = cv[i];
    }
    __syncthreads();
    ew_post<1>(buf, PC + (size_t)(S + t0) * 512, 512, ln_g, ln_b, wid, lane);
    {
        float m[34];
        ew_stage<512, 5>(Z, 3584, t0 - 2, 34, stg, tid);
        __syncthreads();
#pragma unroll
        for (int i = 0; i < 34; ++i) { const int tt = t0 - 2 + i; m[i] = (tt < 0 ? 0.f : 1.f) * bf2f(st16[i * 512 + ch]); }
        __syncthreads();
        ew_stage<512, 4>(Z, 3072, t0, 32, stg, tid);
        __syncthreads();
        const float w0 = sc_w[ch], w1 = sc_w[512 + ch], w2 = sc_w[1024 + ch];
#pragma unroll
        for (int i = 0; i < 32; ++i) buf[i * 512 + ch] = bf2f(st16[i * 512 + ch]) * (w0 * m[i] + w1 * m[i + 1] + w2 * m[i + 2]);
    }
    __syncthreads();
    ew_post<2>(buf, Y + (size_t)t0 * DM + 1536, DM, nullptr, nullptr, wid, lane);
    {
        float seq[47];
        ew_stage<512, 6>(Z, 0, t0 - 15, 47, stg, tid);
        __syncthreads();
#pragma unroll
        for (int i = 0; i < 47; ++i) { const int tt = t0 - 15 + i; seq[i] = (tt < 0 ? 0.f : 1.f) * bf2f(st16[i * 512 + ch]); }
        const int w = 2 << (wid >> 1);
#pragma unroll
        for (int i = 0; i < 32; ++i) { float s = 0.f;
#pragma unroll
            for (int j = 0; j < 16; ++j) s += (j < w) ? seq[15 + i - j] : 0.f;
            const int cnt = (t0 + i + 1) < w ? (t0 + i + 1) : w;
            buf[i * 512 + ch] = s / (float)cnt - seq[15 + i]; }
    }
    __syncthreads();
    ew_post<0>(buf, PC + (size_t)t0 * 512, 512, nullptr, nullptr, wid, lane);
    __syncthreads();
}
__device__ __forceinline__ void scan_head(const float* FL, float bias, float* CLh, int h, LAS unsigned char* lds, int tid) {
    LAS float* sl = (LAS float*)lds;
    LAS double* sd = (LAS double*)(lds + 67584);
    float ls[32];
#pragma unroll
    for (int i = 0; i < 32; ++i) ls[i] = FL[(size_t)(i * 512 + tid) * 4 + h];
    __builtin_amdgcn_sched_barrier(0);
#pragma unroll
    for (int i = 0; i < 32; ++i) { const int e = i * 512 + tid; const float x = ls[i] + bias; const float ex = __builtin_amdgcn_exp2f(-fabsf(x) * LOG2E);
        sl[e + (e >> 5)] = (fminf(x, 0.f) - log1pf(ex)) * LOG2E; }
    __syncthreads();
    double s = 0.0;
#pragma unroll
    for (int i = 0; i < 32; ++i) { ls[i] = sl[tid * 33 + i]; s += (double)ls[i]; }
    sd[tid] = s; __syncthreads();
    for (int off = 1; off < 512; off <<= 1) { const double v = tid >= off ? sd[tid - off] : 0.0; __syncthreads(); sd[tid] += v; __syncthreads(); }
    double run = tid ? sd[tid - 1] : 0.0;
#pragma unroll
    for (int i = 0; i < 32; ++i) { run += (double)ls[i]; sl[tid * 33 + i] = (float)run; }
    __syncthreads();
#pragma unroll
    for (int i = 0; i < 32; ++i) { const int e = i * 512 + tid; CLh[e] = sl[e + (e >> 5)]; }
    __syncthreads();
}

__device__ __forceinline__ att::BlockRef fox_block(const bf16* Z, bf16* Y, const float* CL, float* GSP, int h, int x, int jlo) {
    att::BlockRef b; b.Q = Z + (size_t)(x * 256) * NZ + 1536 + h * 128; b.K = Z + 2048 + h * 128; b.V = Z + 2560 + h * 128; b.O = Y + (size_t)(x * 256) * DM + 1024 + h * 128;
    b.CL = CL + (size_t)h * S; b.P0 = x * 256; b.jlo = jlo; b.Q2 = nullptr; b.GS = GSP + (size_t)(x * 256) * 24 + 16 + h; return b;
}
#define CAS __attribute__((address_space(4)))
struct Args { const float* in[30]; float* out; unsigned char* ws; int ph_lo, ph_hi; };

__global__ void __launch_bounds__(512, 2) fwd_kernel(Args a) {
    extern __shared__ __attribute__((aligned(16))) unsigned char lds[];
    LAS unsigned char* ldsl = (LAS unsigned char*)lds;
    cg::grid_group grid = cg::this_grid();
    const int G = gridDim.x;
    volatile LAS unsigned* stw = (volatile LAS unsigned*)(ldsl + LDS_BYTES - 64);
    if (threadIdx.x < 2) stw[threadIdx.x] = 0u;
    __syncthreads();
    const XcdBarrier xbar = xcd_barrier_post((unsigned*)(a.ws + WS_BAR), stw);
    for (int ph = a.ph_lo; ph < a.ph_hi; ++ph) {
        const int tid = opaque_tid(), lane = tid & 63, wid = __builtin_amdgcn_readfirstlane(tid >> 6);
        int bid = blockIdx.x; asm volatile("" : "+s"(bid));
        const CAS Args* ap = (const CAS Args*)__builtin_amdgcn_kernarg_segment_ptr(); asm volatile("" : "+s"(ap));
        unsigned char* ws = ap->ws; float* X = ap->out;
        const int gw = bid * 8 + wid, NGW = G * 8;
        float* FL = (float*)(ws + WS_FL); float* CL = (float*)(ws + WS_CL);
        bf16* MEMN = (bf16*)(ws + WS_MEMN); bf16* KVX = (bf16*)(ws + WS_KVX); bf16* XB = (bf16*)(ws + WS_XB); bf16* HID = (bf16*)(ws + WS_HID);
        bf16* Z = (bf16*)(ws + WS_Z); bf16* PC = (bf16*)(ws + WS_PC); bf16* Y = (bf16*)(ws + WS_Y); bf16* QX = (bf16*)(ws + WS_QX); bf16* OX = (bf16*)(ws + WS_OX); bf16* QX2 = (bf16*)(ws + WS_QX2); float* GSP = (float*)(ws + WS_GSP);
        bf16* WALL = (bf16*)(ws + WS_W);
        float* NRM = (float*)(ws + WS_CTL);
        float* RSA = (float*)(ws + WS_RSA); float* RSB = (float*)(ws + WS_RSB);
        LAS float* rsl = (LAS float*)(ldsl + 131072);
        if (ph == 0) { if constexpr (PH_EN(16)) {
            LAS float* scr = (LAS float*)(ldsl + wid * 16384);
            constexpr int I_F = (DM / 64) * (DFF / 32), I_MI = (DM / 64) * (NZ / 32), I_PW = 8 * 16, I_MO = 32 * 64, I_X = 32 * 16, I_XO = 8 * 64;
            constexpr int I_FG = DM / 64;
            constexpr int I_LAYER = 6 * I_F + I_MI + I_FG + I_PW + I_MO + 3 * I_X + I_XO;
            for (int it = gw; it < NLAYER * I_LAYER; it += NGW) {
                const int l = it / I_LAYER; int r = it % I_LAYER; bf16* WL = WALL + (size_t)l * LAYER_W;
                const size_t oF = (size_t)l * DM * DFF;
                if (r < I_F) { tr_job(r, ap->in[3] + oF, DFF, DM, DFF, WL + OW_GU1, 0, ap->in[2] + l * DM, 1, scr, lane); continue; } r -= I_F;
                if (r < I_F) { tr_job(r, ap->in[4] + oF, DFF, DM, DFF, WL + OW_GU1, 0, ap->in[2] + l * DM, 2, scr, lane); continue; } r -= I_F;
                if (r < I_F) { tr_job(r, ap->in[5] + oF, DM, DFF, DM, WL + OW_D1, 0, nullptr, 0, scr, lane); continue; } r -= I_F;
                if (r < I_F) { tr_job(r, ap->in[26] + oF, DFF, DM, DFF, WL + OW_GU2, 0, ap->in[25] + l * DM, 1, scr, lane); continue; } r -= I_F;
                if (r < I_F) { tr_job(r, ap->in[27] + oF, DFF, DM, DFF, WL + OW_GU2, 0, ap->in[25] + l * DM, 2, scr, lane); continue; } r -= I_F;
                if (r < I_F) { tr_job(r, ap->in[28] + oF, DM, DFF, DM, WL + OW_D2, 0, nullptr, 0, scr, lane); continue; } r -= I_F;
                if (r < I_MI) { tr_job(r, ap->in[7] + (size_t)l * DM * PIN, PIN, DM, NZ, WL + OW_MI, 0, ap->in[6] + l * DM, 3, scr, lane); continue; } r -= I_MI;
                if (r < I_FG) { tr_item(ap->in[7] + (size_t)l * DM * PIN, PIN, 3072, 64 * r, WL + OW_MI, DM, NZ, ap->in[6] + l * DM, scr, lane); continue; } r -= I_FG;
                if (r < I_PW) { tr_job(r, ap->in[14] + (size_t)l * 512 * 512, 512, 512, 512, WL + OW_PP, 512, nullptr, 0, scr, lane); continue; } r -= I_PW;
                if (r < I_MO) { tr_job(r, ap->in[18] + (size_t)l * DM * DM, DM, DM, DM, WL + OW_MO, 0, ap->in[17] + l * DM, 0, scr, lane); continue; } r -= I_MO;
                if (r < I_X) { tr_job(r, ap->in[21] + (size_t)l * DM * 512, 512, DM, 512, WL + OW_XQ, 0, ap->in[19] + l * DM, 0, scr, lane); continue; } r -= I_X;
                if (r < I_X) { tr_job(r, ap->in[22] + (size_t)l * DM * 512, 512, DM, 512, WL + OW_XKV, 0, ap->in[20] + l * DM, 0, scr, lane); continue; } r -= I_X;
                if (r < I_X) { tr_job(r, ap->in[23] + (size_t)l * DM * 512, 512, DM, 512, WL + OW_XKV, 512, ap->in[20] + l * DM, 0, scr, lane); continue; } r -= I_X;
                tr_job(r, ap->in[24] + (size_t)l * 512 * DM, DM, 512, DM, WL + OW_XO, 0, nullptr, 0, scr, lane);
            }
            for (int idx = bid * 512 + tid; idx < NLAYER * 512 * 512; idx += G * 512) { const int l = idx >> 18, n = (idx >> 9) & 511, k = idx & 511;
                float v = 0.f; if ((n >> 7) == (k >> 7)) v = ap->in[8][(size_t)l * 65536 + (size_t)(n >> 7) * 16384 + (k & 127) * 128 + (n & 127)] * ap->in[9][l * 512 + n];
                (WALL + (size_t)l * LAYER_W + OW_PP)[n * 512 + k] = (bf16)f2bf(v); }
            norm_rows<0>(ap->in[1], MEMN, nullptr, nullptr, nullptr, nullptr, NMEM, gw, NGW, lane);
            split_rows(ap->in[0], XB, RSB, gw, NGW, lane);
        } } else {
            const int l = (ph - 1) >> 4, sub = (ph - 1) & 15;
            if (sub == 2 || sub == 6 || sub == 8 || sub == 12 || (sub == 15 && l + 1 < NLAYER)) continue;
            bf16* WL = WALL + (size_t)l * LAYER_W;
            switch (sub) {
            case 0: case 13: if constexpr (PH_EN(0)) {
                pg8::Gemm g{XB, WL + (sub == 0 ? OW_GU1 : OW_GU2), S, 2 * DFF, DM}; pg8::StaticOrder So; So.init(S, 2 * DFF, G, bid);
                pg8::EpiSwiGLU E{HID, DFF, sub == 0 ? RSB : RSA, rsl};
                pg8::gemm_phase<pg8::EpiSwiGLU, pg8::StaticOrder, true, true>(ldsl, g, So, E);
            } break;
            case 1: case 14: if constexpr (PH_EN(1)) {
                pg8::Gemm g{HID, WL + (sub == 1 ? OW_D1 : OW_D2), S, DM, DFF}; pg8::StaticOrder So; So.init(S, DM, G, bid);
                pg8::EpiResid<false> E{XB, sub == 1 ? RSA : RSB, 0.5f, 0}; pg8::gemm_phase<pg8::EpiResid<false>, pg8::StaticOrder, true, true>(ldsl, g, So, E);
            } break;
            case 2: break;
            case 3: if constexpr (PH_EN(3)) {
                pg8::Gemm g{XB, WL + OW_MI, S, NZP, DM}; pg8::StaticOrder So; So.init(S, NZP, G, bid);
                pg8::EpiBf<0> E{Z, NZ, RSA, rsl, -1, FL, NZ / 256, nullptr, 1};
                pg8::gemm_phase<pg8::EpiBf<0>, pg8::StaticOrder, true, true>(ldsl, g, So, E);
                if (bid >= 192 && bid < 196) {
                    __syncthreads();
                    pg8::Gemm g2{MEMN, WL + OW_XKV, NMEM, 1024, DM, 0}; pg8::StaticOrder S2; S2.init(NMEM, 1024, 64, bid - 192);
                    pg8::EpiBf<0> E2{KVX, 1024, nullptr, rsl, -1, nullptr, 0};
                    pg8::gemm_phase<pg8::EpiBf<0>, pg8::StaticOrder, true, true>(ldsl, g2, S2, E2);
                }
            } break;
            case 4: if constexpr (PH_EN(4)) {
                if (bid < 4) scan_head(FL, ap->in[15][l * 4 + bid], CL + (size_t)bid * S, bid, ldsl, tid);
                for (int c0 = 2 * bid; c0 < S / 32; c0 += 2 * G)
                for (int c = c0; c < c0 + 2; ++c) {
                    const int t2 = opaque_tid();
                    ew_chunk(Z, PC, Y, ap->in[10] + l * 31 * 512, ap->in[11] + l * 512, ap->in[12] + l * 512, ap->in[13] + l * 512, ap->in[16] + l * 3 * 512, NRM, (LAS float*)ldsl, c, t2, __builtin_amdgcn_readfirstlane(t2 >> 6), t2 & 63);
                }
            } break;
            case 5: if constexpr (PH_EN(5)) {
                { pg8::Gemm g{PC, WL + OW_PP, 2 * S, 1024, 512}; pg8::PPOrder So{G, bid}; pg8::EpiBf<1> E{Y, DM, nullptr, rsl, -1, nullptr, 0, GSP};
                  pg8::gemm_phase<pg8::EpiBf<1>, pg8::PPOrder, true, true>(ldsl, g, So, E); }
                __syncthreads();
                for (int item = bid; item < 256; item += G) {
                    const int h = item & 3, qb = item >> 2;
                    float km, qm = 0.f;
                    { const f32x4 kv = *(const f32x4*)(NRM + (size_t)(4 + h) * 2048 + 4 * tid); km = fmaxf(fmaxf(kv[0], kv[1]), fmaxf(kv[2], kv[3]));
                      if (tid < 8) { const f32x4 qv = *(const f32x4*)(NRM + (size_t)h * 2048 + 32 * qb + 4 * tid); qm = fmaxf(fmaxf(qv[0], qv[1]), fmaxf(qv[2], qv[3])); }
#pragma unroll
                      for (int o = 1; o < 64; o <<= 1) { km = fmaxf(km, __shfl_xor(km, o)); qm = fmaxf(qm, __shfl_xor(qm, o)); }
                      LAS float* red = (LAS float*)(ldsl + 139264);
                      if (lane == 0) { red[wid] = km; red[8 + wid] = qm; }
                      __syncthreads();
#pragma unroll
                      for (int w8 = 0; w8 < 8; ++w8) { km = fmaxf(km, red[w8]); qm = fmaxf(qm, red[8 + w8]); } }
                    const float qk = 2.0f * att::C2 * 1.001f * sqrtf(qm * km);
                    const float* CLh = CL + (size_t)h * S;
                    const bool skip = (tid < qb * 4) && (CLh[qb * 256] - CLh[64 * tid + 63] + qk < -48.0f);
                    int jlo;
                    { LAS int* cnt8 = (LAS int*)(ldsl + 139264 + 128);
                      const int wc_ = __popcll(__ballot(skip)); if (lane == 0) cnt8[wid] = wc_;
                      __syncthreads();
                      int tot = 0;
#pragma unroll
                      for (int w8 = 0; w8 < 8; ++w8) tot += cnt8[w8];
                      jlo = __builtin_amdgcn_readfirstlane(tot); }
                    att::Seam Sm;
                    const att::BlockRef cur = fox_block(Z, Y, CL, GSP, h, qb, jlo);
                    att::attn_prime<NZ, NZ>(cur, (char*)lds, Sm);
                    att::attn_block<true, NZ, NZ, DM>(cur, cur, S, 0x40000000u, (char*)lds, (LAS float*)(ldsl + att::CLDS_OFF), Sm);
                    asm volatile("s_waitcnt vmcnt(0)" ::: "memory"); __syncthreads();
                }
            } break;
            case 6: if constexpr (PH_EN(6)) group_norm_rows(Y, gw, NGW, lane); break;
            case 7: if constexpr (PH_EN(7)) {
                pg8::Gemm g{Y, WL + OW_MO, S, DM, DM}; pg8::StaticOrder So; So.init(S, DM, G, bid);
                pg8::EpiResid<true> E{XB, RSB, 1.0f, 0, GSP, (LAS float*)(ldsl + 131072 + 1024), -1};
                pg8::gemm_phase<pg8::EpiResid<true>, pg8::StaticOrder, true, true>(ldsl, g, So, E);
            } break;
            case 8: case 12: if constexpr (PH_EN(8)) norm_rows<0>(X, XB, nullptr, nullptr, nullptr, nullptr, S, gw, NGW, lane); break;
            case 9: if constexpr (PH_EN(9)) {
                const int kh = bid >> 7;
                pg8::Gemm g{XB + kh * 1024, WL + OW_XQ + kh * 1024, S, 512, 1024, DM}; pg8::StaticOrder So; So.init(S, 512, 128, bid & 127);
                pg8::EpiBf<0> E{kh ? QX2 : QX, 512, RSB, rsl, -1, nullptr, 0};
                pg8::gemm_phase<pg8::EpiBf<0>, pg8::StaticOrder, true, true>(ldsl, g, So, E);
            } break;
            case 10: if constexpr (PH_EN(10)) {
                for (int item = bid; item < 256; item += G) {
                    const int h = item & 3, qb = item >> 2;
                    att::BlockRef b0;
                    b0.Q = QX + (size_t)(qb * 256) * 512 + h * 128; b0.K = KVX + h * 128; b0.V = KVX + 512 + h * 128; b0.O = OX + (size_t)(qb * 256) * 512 + h * 128;
                    b0.CL = nullptr; b0.P0 = 256; b0.jlo = 0; b0.Q2 = QX2 + (size_t)(qb * 256) * 512 + h * 128; b0.GS = nullptr;
                    att::Seam Sm;
                    att::attn_prime<512, 1024, true>(b0, (char*)lds, Sm);
                    att::attn_block<false, 512, 1024, 512>(b0, b0, NMEM, 0x40000000u, (char*)lds, (LAS float*)(ldsl + att::CLDS_OFF), Sm);
                    asm volatile("s_waitcnt vmcnt(0)" ::: "memory"); __syncthreads();
                }
            } break;
            case 11: if constexpr (PH_EN(11)) {
                pg8::Gemm g{OX, WL + OW_XO, S, DM, 512}; pg8::StaticOrder So; So.init(S, DM, G, bid);
                pg8::EpiResid<false> E{XB, RSA, 1.0f, 0};
                pg8::gemm_phase<pg8::EpiResid<false>, pg8::StaticOrder, true, true>(ldsl, g, So, E);
            } break;
            case 15: if constexpr (PH_EN(15)) {
                if (l + 1 < NLAYER) norm_rows<0>(X, XB, nullptr, nullptr, nullptr, nullptr, S, gw, NGW, lane);
                else final_rows(XB, RSB, ap->in[29], X, gw, NGW, lane); }
                break;
            }
        }
        if (ph + 1 < a.ph_hi) { if (ph == 0) grid.sync(); else xcd_barrier(xbar); }
    }
}

extern "C" void kernel_launch(void* const* d_in, const int* in_sizes, int n_in, void* d_out, int out_size, void* d_ws, size_t ws_size, hipStream_t stream) {
    static int grid = 0;
    if (grid == 0) {
        if (n_in != 30 || in_sizes[0] != S * DM || out_size != S * DM || ws_size < WS_NEED) { fprintf(stderr, "kernel_launch: unexpected shapes (n_in %d, in0 %d, out %d, ws %zu)\n", n_in, n_in > 0 ? in_sizes[0] : -1, out_size, ws_size); grid = -1; return; }
        int dev = 0, cus = 0, per_cu = 0;
        if (hipGetDevice(&dev) != hipSuccess || hipDeviceGetAttribute(&cus, hipDeviceAttributeMultiprocessorCount, dev) != hipSuccess) { grid = -1; return; }
        if (hipFuncSetAttribute((const void*)fwd_kernel, hipFuncAttributeMaxDynamicSharedMemorySize, LDS_BYTES) != hipSuccess) { fprintf(stderr, "kernel_launch: hipFuncSetAttribute failed\n"); grid = -1; return; }
        if (hipOccupancyMaxActiveBlocksPerMultiprocessor(&per_cu, (const void*)fwd_kernel, 512, LDS_BYTES) != hipSuccess || per_cu < 1) { fprintf(stderr, "kernel_launch: occupancy query says %d\n", per_cu); per_cu = 1; }
        (void)hipGetLastError();
        grid = cus;
        if (grid != 256) { fprintf(stderr, "kernel_launch: built for a 256-CU device, found %d CUs\n", cus); grid = -1; return; }
    }
    if (grid < 0) return;
    if (hipMemsetAsync((char*)d_ws + WS_BAR, 0, XCD_BAR_WORDS * 4, stream) != hipSuccess) { fprintf(stderr, "kernel_launch: memset of the barrier words failed\n"); return; }
    Args a{};
    for (int i = 0; i < 30; ++i) a.in[i] = (const float*)d_in[i];
    a.out = (float*)d_out; a.ws = (unsigned char*)d_ws;
#if MK_PER_PHASE
    for (int ph = 0; ph < NPH; ++ph) { a.ph_lo = ph; a.ph_hi = ph + 1; hipLaunchKernelGGL(fwd_kernel, dim3(grid), dim3(512), LDS_BYTES, stream, a); }
#else
    a.ph_lo = 0; a.ph_hi = NPH;
    void* args[] = {&a};
    hipError_t e = hipLaunchCooperativeKernel((const void*)fwd_kernel, dim3(grid), dim3(512), args, LDS_BYTES, stream);
    if (e != hipSuccess) fprintf(stderr, "kernel_launch: cooperative launch failed: %s\n", hipGetErrorString(e));
#endif
}
```

```cpp
#define MK_PER_PHASE 0
#include <hip/hip_runtime.h>
#include <hip/hip_cooperative_groups.h>
#include <cstdio>
#include <cstdint>
namespace cg = cooperative_groups;
#define LAS __attribute__((address_space(3)))
typedef short bf16x8 __attribute__((ext_vector_type(8)));
typedef short s16x4 __attribute__((ext_vector_type(4)));
typedef float f32x4 __attribute__((ext_vector_type(4)));
typedef float f32x16 __attribute__((ext_vector_type(16)));
typedef unsigned u32x4 __attribute__((ext_vector_type(4)));
__device__ __forceinline__ int opaque_tid() { int t = threadIdx.x; asm volatile("" : "+v"(t)); return t; }
namespace pg8 {
#define PG8_LAS __attribute__((address_space(3)))
typedef unsigned short bf16_t;
typedef short bf16x8 __attribute__((ext_vector_type(8)));
typedef float f32x4 __attribute__((ext_vector_type(4)));
typedef unsigned u32x4 __attribute__((ext_vector_type(4)));
constexpr int BM = 256, BK = 64, HALF = 128, HTB = HALF * BK * 2  , STAGE_BYTES = 8 * HTB, NXCD = 8, WGM = 8;

__host__ __device__ __forceinline__ int lds_byte(int r, int c) { const int st = (r >> 4) * 2 + (c >> 5), rr = r & 15, cc = c & 31, ob = rr * 64 + cc * 2; return st * 1024 + (ob ^ (((ob >> 9) & 1) << 5)); }
__host__ __device__ __forceinline__ void stage_rc(int b, int& R, int& C) { const int st = b / 1024, sb = b % 1024, swz = sb ^ (((sb >> 9) & 1) << 5); R = (st >> 1) * 16 + swz / 64; C = (st & 1) * 32 + (swz % 64) / 2; }
__host__ __device__ __forceinline__ int perm32(int rho) { const int n = rho >> 4, i = rho & 15; return 8 * (i >> 2) + 4 * n + (i & 3); }

struct Unit { int pm, pn; };
struct Gemm { const bf16_t* A; const bf16_t* Bt; int M, N, K; int ld; };

struct StaticOrder {
    int nM, nN, nwg, G, c;
    __host__ __device__ void init(int M, int N, int G_, int c_) { nM = M / BM; nN = N / BM; nwg = nM * nN; G = G_; c = c_; }
    __host__ __device__ bool next(int i, Unit& u) const {
        const long L = (long)i * G + c; if (L >= nwg) return false;
        int wgid = (int)L; { const int q = nwg / NXCD, r = nwg % NXCD, xcd = wgid % NXCD, off = wgid / NXCD; wgid = (xcd < r ? xcd * (q + 1) : r * (q + 1) + (xcd - r) * q) + off; }
        const int nig = WGM * nN, gid = wgid / nig, fm = gid * WGM, gsz = (nM - fm) < WGM ? (nM - fm) : WGM;
        u.pm = fm + ((wgid % nig) % gsz); u.pn = (wgid % nig) / gsz; return true;
    }
    __device__ __forceinline__ void a_ready(const Unit&) const {}
    __device__ __forceinline__ void done(const Unit&) const {}
};

__device__ __forceinline__ unsigned cvt_pk_bf16(float lo, float hi) { unsigned r; asm volatile("v_cvt_pk_bf16_f32 %0, %1, %2" : "=v"(r) : "v"(lo), "v"(hi)); return r; }

__device__ __forceinline__ float silu_f(float g) { return g * __builtin_amdgcn_rcpf(1.0f + __builtin_amdgcn_exp2f(-1.4426950408889634f * g)); }

__device__ __forceinline__ void rstd_to_lds(const float* RSP, PG8_LAS float* rsl, int pm) {
    const int t = opaque_tid(), row = t >> 1, half = t & 1;
    const f32x4* p = (const f32x4*)(RSP + ((size_t)(pm * BM + row)) * 32 + half * 16);
    const f32x4 a = p[0], b = p[1], c = p[2], d = p[3];
    float s = ((a[0] + a[1]) + (a[2] + a[3])) + ((b[0] + b[1]) + (b[2] + b[3])) + ((c[0] + c[1]) + (c[2] + c[3])) + ((d[0] + d[1]) + (d[2] + d[3]));
    s += __shfl_xor(s, 1);
    if (half == 0) rsl[row] = 1.0f / sqrtf(s * (1.0f / 2048.0f) + 1e-6f);
    asm volatile("s_waitcnt lgkmcnt(0)" ::: "memory"); __builtin_amdgcn_s_barrier(); asm volatile("" ::: "memory");
}
struct EpiSwiGLU {
    static constexpr bool PERM = true, AFTER_DRAIN = false, KSEG = false;
    bf16_t* O; int ldc; const float* RSP; PG8_LAS float* rsl;
    mutable int last_pm = -1;
    __device__ __forceinline__ void operator()(const f32x4 (&acc)[2][2][4][2], const Unit& u, int wr, int wc, int fr, int fq) const {
        if (u.pm != last_pm) { rstd_to_lds(RSP, rsl, u.pm); last_pm = u.pm; }
        const int row0 = u.pm * BM + wr * 64 + fr, col0 = u.pn * HALF + wc * 32 + 8 * fq;
#pragma unroll
        for (int ai = 0; ai < 2; ++ai)
#pragma unroll
            for (int m = 0; m < 4; ++m) { const int row = row0 + ai * HALF + m * 16; bf16_t* rowp = O + (size_t)row * ldc + col0;
                const float rs = rsl[wr * 64 + fr + ai * HALF + m * 16], cexp = -1.4426950408889634f * rs, rs2 = rs * rs;
                u32x4 w;
#pragma unroll
                for (int n = 0; n < 2; ++n) { const f32x4 g = acc[ai][0][m][n], uu = acc[ai][1][m][n];
                    f32x4 e = g * cexp;
                    e[0] = __builtin_amdgcn_exp2f(e[0]); e[1] = __builtin_amdgcn_exp2f(e[1]); e[2] = __builtin_amdgcn_exp2f(e[2]); e[3] = __builtin_amdgcn_exp2f(e[3]);
                    f32x4 r = e + 1.0f;
                    r[0] = __builtin_amdgcn_rcpf(r[0]); r[1] = __builtin_amdgcn_rcpf(r[1]); r[2] = __builtin_amdgcn_rcpf(r[2]); r[3] = __builtin_amdgcn_rcpf(r[3]);
                    const f32x4 o = ((g * uu) * rs2) * r;
                    w[2 * n] = cvt_pk_bf16(o[0], o[1]); w[2 * n + 1] = cvt_pk_bf16(o[2], o[3]); }
                *(u32x4*)rowp = w; }
    }
};
template <bool FLG> struct EpiResid {
    static constexpr bool PERM = true, AFTER_DRAIN = false, KSEG = FLG;
    bf16_t* XH; float* RSP; float alpha; int pad_;
    const float* GSP = nullptr; PG8_LAS float* gtab = nullptr; mutable int last_pm = -1;
    __device__ __forceinline__ void prep(const Unit& u) const {
        if (u.pm == last_pm) return;
        last_pm = u.pm;
        const int t = opaque_tid();
        if (t < 256) { const f32x4* p = (const f32x4*)(GSP + (size_t)(u.pm * BM + t) * 24);
            const f32x4 a0 = p[0], a1 = p[1], b0 = p[2], b1 = p[3], c0 = p[4];
            const float sa = ((a0[0] + a0[1]) + (a0[2] + a0[3])) + ((a1[0] + a1[1]) + (a1[2] + a1[3])), sb = ((b0[0] + b0[1]) + (b0[2] + b0[3])) + ((b1[0] + b1[1]) + (b1[2] + b1[3])), sc = (c0[0] + c0[1]) + (c0[2] + c0[3]);
            const float r0 = 1.0f / sqrtf(sa * (1.0f / 512.0f) + 1e-6f), r1 = 1.0f / sqrtf(sb * (1.0f / 512.0f) + 1e-6f), r2 = 1.0f / sqrtf(sc * (1.0f / 512.0f) + 1e-6f);
            gtab[t] = r0 / r1; gtab[256 + t] = r1 / r2; gtab[512 + t] = r2; }
        asm volatile("s_waitcnt lgkmcnt(0)" ::: "memory"); __builtin_amdgcn_s_barrier(); asm volatile("" ::: "memory");
    }
    __device__ __forceinline__ void rescale(f32x4 (&acc)[2][2][4][2], int seg, int wr, int fr) const {
#pragma unroll
        for (int ai = 0; ai < 2; ++ai)
#pragma unroll
            for (int m = 0; m < 4; ++m) { const float rho = gtab[(seg - 1) * 256 + wr * 64 + fr + ai * HALF + m * 16];
#pragma unroll
                for (int bj = 0; bj < 2; ++bj)
#pragma unroll
                    for (int n = 0; n < 2; ++n) acc[ai][bj][m][n] = acc[ai][bj][m][n] * rho; }
    }
    __device__ __forceinline__ void operator()(const f32x4 (&acc)[2][2][4][2], const Unit& u, int wr, int wc, int fr, int fq) const {
        const int row0 = u.pm * BM + wr * 64 + fr, col0 = u.pn * BM + wc * 32 + 8 * fq;
#pragma unroll
        for (int ai = 0; ai < 2; ++ai)
#pragma unroll
            for (int mh = 0; mh < 2; ++mh) {
                u32x4 h[2][2];
#pragma unroll
                for (int m2 = 0; m2 < 2; ++m2)
#pragma unroll
                    for (int bj = 0; bj < 2; ++bj) { const size_t off = (size_t)(row0 + ai * HALF + (mh * 2 + m2) * 16) * 2048 + col0 + bj * HALF;
                        h[m2][bj] = *(const u32x4*)(XH + off); }
                __builtin_amdgcn_sched_barrier(0);
#pragma unroll
                for (int m2 = 0; m2 < 2; ++m2) { const int m = mh * 2 + m2, row = row0 + ai * HALF + m * 16;
                    float ss = 0.f;
#pragma unroll
                    for (int bj = 0; bj < 2; ++bj) { const size_t off = (size_t)row * 2048 + col0 + bj * HALF; u32x4 nh;
#pragma unroll
                        for (int w = 0; w < 4; ++w) { const unsigned hw = h[m2][bj][w];
                            const float a0 = acc[ai][bj][m][w >> 1][(w & 1) * 2], a1 = acc[ai][bj][m][w >> 1][(w & 1) * 2 + 1];
                            const float v0 = __uint_as_float(hw << 16) + a0 * alpha, v1 = __uint_as_float(hw & 0xffff0000u) + a1 * alpha;
                            const unsigned ph = cvt_pk_bf16(v0, v1);
                            nh[w] = ph;
                            ss += v0 * v0 + v1 * v1; }
                        *(u32x4*)(XH + off) = nh; }
                    ss += __shfl_xor(ss, 16); ss += __shfl_xor(ss, 32);
                    if (fq == 0) RSP[(size_t)row * 32 + u.pn * 4 + wc] = ss; }
                __builtin_amdgcn_sched_barrier(0);
            }
    }
};
template <int MODE> struct EpiBf {
    static constexpr bool PERM = true, AFTER_DRAIN = false, KSEG = false;
    bf16_t* O; int ldc; const float* RSP; PG8_LAS float* rsl;
    mutable int last_pm = -1;
    float* FLp; int fl_tile; float* GSP = nullptr; int mixmode = 0;
    __device__ __forceinline__ void operator()(const f32x4 (&acc)[2][2][4][2], const Unit& u, int wr, int wc, int fr, int fq) const {
        if (MODE == 0 && RSP && u.pm != last_pm) { rstd_to_lds(RSP, rsl, u.pm); last_pm = u.pm; }
        if (MODE == 0 && FLp && u.pn == fl_tile) {
            if (wc == 0 && fq == 0) {
#pragma unroll
                for (int ai = 0; ai < 2; ++ai)
#pragma unroll
                    for (int m = 0; m < 4; ++m) { const int row = u.pm * BM + wr * 64 + fr + ai * HALF + m * 16;
                        const float rs = rsl[wr * 64 + fr + ai * HALF + m * 16];
                        *(f32x4*)(FLp + (size_t)row * 4) = acc[ai][0][m][0] * rs; } }
            return; }
        if (MODE == 0 && mixmode && ((u.pn >= 2 && u.pn < 6) || (u.pn >= 14 && u.pn < 18))) {
            const bool glu = u.pn < 6; const int ocol = (glu ? 512 + 128 * (u.pn - 2) : 3584 + 128 * (u.pn - 14)) + wc * 32 + 8 * fq;
#pragma unroll
            for (int ai = 0; ai < 2; ++ai)
#pragma unroll
                for (int m = 0; m < 4; ++m) { const int row = u.pm * BM + wr * 64 + fr + ai * HALF + m * 16; const float rs = rsl[wr * 64 + fr + ai * HALF + m * 16];
                    const f32x4 a0 = acc[ai][0][m][0] * rs, a1 = acc[ai][0][m][1] * rs; f32x4 g0 = acc[ai][1][m][0] * rs, g1 = acc[ai][1][m][1] * rs;
                    if (glu) {
#pragma unroll
                        for (int e = 0; e < 4; ++e) { g0[e] = __builtin_amdgcn_rcpf(1.0f + __builtin_amdgcn_exp2f(-1.4426950408889634f * g0[e])); g1[e] = __builtin_amdgcn_rcpf(1.0f + __builtin_amdgcn_exp2f(-1.4426950408889634f * g1[e])); } }
                    const f32x4 v0 = a0 * g0, v1 = a1 * g1;
                    u32x4 w; w.x = cvt_pk_bf16(v0[0], v0[1]); w.y = cvt_pk_bf16(v0[2], v0[3]); w.z = cvt_pk_bf16(v1[0], v1[1]); w.w = cvt_pk_bf16(v1[2], v1[3]);
                    *(u32x4*)(O + (size_t)row * ldc + ocol) = w; }
            return; }
        int prow = u.pm, pcol = u.pn * BM;
        if (MODE == 1) { prow = u.pm & 63; pcol = (u.pm >> 6) * 512 + (u.pn & 1) * 256; }
        const int row0 = prow * BM + wr * 64 + fr, col0 = pcol + wc * 32 + 8 * fq;
#pragma unroll
        for (int ai = 0; ai < 2; ++ai)
#pragma unroll
            for (int m = 0; m < 4; ++m) { const int row = row0 + ai * HALF + m * 16; bf16_t* rowp = O + (size_t)row * ldc + col0;
                const float rs = (MODE == 0 && RSP) ? rsl[wr * 64 + fr + ai * HALF + m * 16] : 1.0f;
                float ss = 0.f;
#pragma unroll
                for (int bj = 0; bj < 2; ++bj) { const f32x4 v0 = acc[ai][bj][m][0] * rs, v1 = acc[ai][bj][m][1] * rs;
                    u32x4 w; w.x = cvt_pk_bf16(v0[0], v0[1]); w.y = cvt_pk_bf16(v0[2], v0[3]); w.z = cvt_pk_bf16(v1[0], v1[1]); w.w = cvt_pk_bf16(v1[2], v1[3]);
                    if (MODE == 1) ss += ((v0[0] * v0[0] + v0[1] * v0[1]) + (v0[2] * v0[2] + v0[3] * v0[3])) + ((v1[0] * v1[0] + v1[1] * v1[1]) + (v1[2] * v1[2] + v1[3] * v1[3]));
                    *(u32x4*)(rowp + bj * HALF) = w; }
                if (MODE == 1) { ss += __shfl_xor(ss, 16); ss += __shfl_xor(ss, 32);
                    if (fq == 0) GSP[(size_t)row * 24 + (u.pm >> 6) * 8 + (u.pn & 1) * 4 + wc] = ss; } }
    }
};
struct PPOrder {
    int G, c;
    __device__ __forceinline__ bool next(int i, Unit& u) const { const int L = i * G + c; if (L >= 256) return false; u.pm = L >> 1; u.pn = (L & 1) + ((L >> 7) << 1); return true; }
    __device__ __forceinline__ void a_ready(const Unit&) const {}
    __device__ __forceinline__ void done(const Unit&) const {}
};
template <class Epi, class Sched, bool ALIGN_EPI = false, bool SP2 = false>
__device__ __forceinline__ void gemm_phase(PG8_LAS unsigned char* lds, const Gemm g, const Sched& S, const Epi& E) {
    const int tid = opaque_tid(), wid = __builtin_amdgcn_readfirstlane(tid >> 6), lane = tid & 63, wr = wid >> 2, wc = wid & 3, fr = lane & 15, fq = lane >> 4;
    const int K = g.K, nt = K / BK, LD = g.ld ? g.ld : K;
    unsigned voffA[2], voffB[2];
#pragma unroll
    for (int i = 0; i < 2; ++i) { int R, C; stage_rc(tid * 16 + i * 8192, R, C); const int Rb = Epi::PERM ? ((R & ~31) + perm32(R & 31)) : R;
        voffA[i] = (unsigned)(R * LD + C) * 2u; voffB[i] = (unsigned)(Rb * LD + C) * 2u; }
    const size_t kstep = (size_t)(BK * 2);
    const size_t hstep = (size_t)HALF * LD * 2;
    const size_t tstep = 2 * hstep;
    const unsigned ldsw = (unsigned)wid * 1024u;
    const int aoff = lds_byte(wr * 64 + fr, fq * 8), boff = lds_byte(wc * 32 + fr, fq * 8);
#define PG8_SA(b, h) (((b) * 2 + (h)) * HTB)
#define PG8_SB(b, h) ((4 + (b) * 2 + (h)) * HTB)
#define PG8_STAGE(bufoff, gbase, voff) do { _Pragma("unroll") for (int _i = 0; _i < 2; ++_i) \
        __builtin_amdgcn_global_load_lds((const unsigned*)((const char*)(gbase) + (voff)[_i]), (PG8_LAS unsigned*)(lds + (bufoff) + ldsw + _i * 8192), 16, 0, 0); } while (0)
#define PG8_LDA(dst, b, h) do { _Pragma("unroll") for (int m = 0; m < 4; ++m) _Pragma("unroll") for (int k = 0; k < 2; ++k) dst[m][k] = *(const PG8_LAS bf16x8*)(lds + PG8_SA(b, h) + aoff + m * 2048 + k * 1024); } while (0)
#define PG8_LDB(dst, b, h) do { _Pragma("unroll") for (int n = 0; n < 2; ++n) _Pragma("unroll") for (int k = 0; k < 2; ++k) dst[n][k] = *(const PG8_LAS bf16x8*)(lds + PG8_SB(b, h) + boff + n * 2048 + k * 1024); } while (0)
#define PG8_MMA(ai, bj, At, Bt) do { __builtin_amdgcn_s_setprio(1); _Pragma("unroll") for (int m = 0; m < 4; ++m) _Pragma("unroll") for (int n = 0; n < 2; ++n) _Pragma("unroll") for (int k = 0; k < 2; ++k) \
        acc[ai][bj][m][n] = __builtin_amdgcn_mfma_f32_16x16x32_bf16(Bt[n][k], At[m][k], acc[ai][bj][m][n], 0, 0, 0); __builtin_amdgcn_s_setprio(0); } while (0)
#define PG8_WAIT_V(n) asm volatile("s_waitcnt vmcnt(" #n ")" ::: "memory")
#define PG8_WAIT_L(n) asm volatile("s_waitcnt lgkmcnt(" #n ")" ::: "memory")
#define PG8_BAR __builtin_amdgcn_s_barrier()
#define PG8_SCHED __builtin_amdgcn_sched_barrier(0)
    Unit cur, nxt; int ui = 0;
    if (!S.next(0, cur)) return;
    f32x4 acc[2][2][4][2];
#pragma unroll
    for (int a = 0; a < 2; ++a)
#pragma unroll
        for (int b = 0; b < 2; ++b)
#pragma unroll
            for (int m = 0; m < 4; ++m)
#pragma unroll
                for (int n = 0; n < 2; ++n) acc[a][b][m][n] = (f32x4){0.f, 0.f, 0.f, 0.f};
    bf16x8 At[4][2], B0[2][2], B1[2][2];
    const char* cA = (const char*)g.A + (size_t)cur.pm * tstep; const char* cB = (const char*)g.Bt + (size_t)cur.pn * tstep;
    if constexpr (Epi::KSEG) E.prep(cur);
    S.a_ready(cur);
    if constexpr (SP2) {
        PG8_STAGE(PG8_SB(0, 0), cB, voffB); PG8_STAGE(PG8_SB(0, 1), cB + hstep, voffB); PG8_STAGE(PG8_SA(0, 0), cA, voffA); PG8_STAGE(PG8_SA(0, 1), cA + hstep, voffA);
        if (wr == 1) PG8_BAR;
        PG8_WAIT_V(2); PG8_BAR;
        PG8_STAGE(PG8_SB(1, 0), cB + kstep, voffB); PG8_STAGE(PG8_SA(1, 0), cA + kstep, voffA); PG8_STAGE(PG8_SB(1, 1), cB + hstep + kstep, voffB);
        PG8_WAIT_V(6); PG8_BAR;
    } else {
        PG8_STAGE(PG8_SB(0, 0), cB, voffB); PG8_STAGE(PG8_SA(0, 0), cA, voffA); PG8_STAGE(PG8_SB(0, 1), cB + hstep, voffB); PG8_STAGE(PG8_SA(0, 1), cA + hstep, voffA);
        if (wr == 1) PG8_BAR;
        PG8_WAIT_V(4); PG8_BAR;
        PG8_STAGE(PG8_SB(1, 0), cB + kstep, voffB); PG8_STAGE(PG8_SA(1, 0), cA + kstep, voffA); PG8_STAGE(PG8_SB(1, 1), cB + hstep + kstep, voffB);
        PG8_WAIT_V(6); PG8_BAR;
    }
    for (;;) {
        const bool has_next = S.next(ui + 1, nxt);
        const char* nA = has_next ? (const char*)g.A + (size_t)nxt.pm * tstep : cA; const char* nB = has_next ? (const char*)g.Bt + (size_t)nxt.pn * tstep : cB;
        for (int t = 0; t < nt; t += 2) {
            if constexpr (Epi::KSEG) { if (t == 8 || t == 16 || t == 24) E.rescale(acc, t >> 3, wr, fr); }
            const bool last = (t == nt - 2);
            const char* a1 = cA + (size_t)(t + 1) * kstep;
            const char* a2 = last ? nA : cA + (size_t)(t + 2) * kstep; const char* b2 = last ? nB : cB + (size_t)(t + 2) * kstep;
            const char* a3 = a2 + kstep; const char* b3 = b2 + kstep;
            if (last && has_next) S.a_ready(nxt);
            if constexpr (SP2) {
            PG8_LDB(B0, 0, 0); PG8_LDB(B1, 0, 1); PG8_SCHED; PG8_LDA(At, 0, 0); PG8_STAGE(PG8_SA(1, 1), a1 + hstep, voffA);
            PG8_WAIT_V(8); PG8_WAIT_L(0); PG8_BAR; PG8_MMA(0, 0, At, B0); PG8_MMA(0, 1, At, B1); PG8_BAR; PG8_SCHED;
            PG8_LDA(At, 0, 1); PG8_STAGE(PG8_SB(0, 0), b2, voffB); PG8_STAGE(PG8_SB(0, 1), b2 + hstep, voffB); PG8_STAGE(PG8_SA(0, 0), a2, voffA);
            PG8_WAIT_V(8); PG8_WAIT_L(0); PG8_BAR; PG8_MMA(1, 0, At, B0); PG8_MMA(1, 1, At, B1); PG8_BAR; PG8_SCHED;
            PG8_LDB(B0, 1, 0); PG8_LDB(B1, 1, 1); PG8_SCHED; PG8_LDA(At, 1, 0); PG8_STAGE(PG8_SA(0, 1), a2 + hstep, voffA);
            PG8_WAIT_V(8); PG8_WAIT_L(0); PG8_BAR; PG8_MMA(0, 0, At, B0); PG8_MMA(0, 1, At, B1); PG8_BAR; PG8_SCHED;
            PG8_LDA(At, 1, 1); PG8_STAGE(PG8_SB(1, 0), b3, voffB); PG8_STAGE(PG8_SB(1, 1), b3 + hstep, voffB); PG8_STAGE(PG8_SA(1, 0), a3, voffA);
            PG8_WAIT_V(8); PG8_WAIT_L(0); PG8_BAR; PG8_MMA(1, 0, At, B0); PG8_MMA(1, 1, At, B1); PG8_BAR; PG8_SCHED;
            } else {
            PG8_LDB(B0, 0, 0); PG8_SCHED; PG8_LDA(At, 0, 0); PG8_STAGE(PG8_SA(1, 1), a1 + hstep, voffA);
            PG8_WAIT_L(8); PG8_BAR; PG8_WAIT_L(0); PG8_MMA(0, 0, At, B0); PG8_BAR; PG8_SCHED;
            PG8_LDB(B1, 0, 1); PG8_STAGE(PG8_SB(0, 0), b2, voffB);
            PG8_BAR; PG8_WAIT_L(0); PG8_MMA(0, 1, At, B1); PG8_BAR;
            PG8_LDA(At, 0, 1); PG8_STAGE(PG8_SA(0, 0), a2, voffA);
            PG8_BAR; PG8_WAIT_L(0); PG8_MMA(1, 0, At, B0); PG8_BAR; PG8_SCHED;
            PG8_STAGE(PG8_SB(0, 1), b2 + hstep, voffB);
            PG8_WAIT_V(6); PG8_BAR; PG8_MMA(1, 1, At, B1); PG8_BAR;
            PG8_LDB(B0, 1, 0); PG8_SCHED; PG8_LDA(At, 1, 0); PG8_STAGE(PG8_SA(0, 1), a2 + hstep, voffA);
            PG8_WAIT_L(8); PG8_BAR; PG8_WAIT_L(0); PG8_MMA(0, 0, At, B0); PG8_BAR; PG8_SCHED;
            PG8_LDB(B1, 1, 1); PG8_STAGE(PG8_SB(1, 0), b3, voffB);
            PG8_BAR; PG8_WAIT_L(0); PG8_MMA(0, 1, At, B1); PG8_BAR;
            PG8_LDA(At, 1, 1); PG8_STAGE(PG8_SA(1, 0), a3, voffA);
            PG8_BAR; PG8_WAIT_L(0); PG8_MMA(1, 0, At, B0); PG8_BAR; PG8_SCHED;
            PG8_STAGE(PG8_SB(1, 1), b3 + hstep, voffB);
            PG8_WAIT_V(6); PG8_BAR; PG8_MMA(1, 1, At, B1); PG8_BAR;
            }
        }
        if constexpr (ALIGN_EPI) { if (wr == 0) PG8_BAR; }
        if constexpr (!Epi::AFTER_DRAIN) { E(acc, cur, wr, wc, fr, fq); S.done(cur); }
        if (!has_next) break;
#pragma unroll
        for (int a = 0; a < 2; ++a)
#pragma unroll
            for (int b = 0; b < 2; ++b)
#pragma unroll
                for (int m = 0; m < 4; ++m)
#pragma unroll
                    for (int n = 0; n < 2; ++n) acc[a][b][m][n] = (f32x4){0.f, 0.f, 0.f, 0.f};
        cur = nxt; cA = nA; cB = nB; ++ui;
        if constexpr (Epi::KSEG) E.prep(cur);
        if constexpr (ALIGN_EPI) { if (wr == 1) PG8_BAR; }
    }
    PG8_WAIT_V(0);
    if constexpr (!ALIGN_EPI) { if (wr == 0) PG8_BAR; }
    PG8_BAR;
    if constexpr (Epi::AFTER_DRAIN) { E.fused(acc, cur, wr, wc, fr, fq, lds, wid, lane); S.done(cur); }
#undef PG8_SA
#undef PG8_SB
#undef PG8_STAGE
#undef PG8_LDA
#undef PG8_LDB
#undef PG8_MMA
#undef PG8_WAIT_V
#undef PG8_WAIT_L
#undef PG8_BAR
#undef PG8_SCHED
}
}
namespace att {
constexpr int D = 128, NW = 8, QBLK = 32, KVBLK = 64, QB = NW * QBLK;
constexpr int SHM_V = KVBLK * D * 2, SHM_K = KVBLK * D * 2;
constexpr int LDS_ATT = 2 * SHM_V + 2 * SHM_K + NW * 64 * 4;
constexpr int CLDS_OFF = LDS_ATT;
constexpr float SCALE = 0.08838834764831845f;
constexpr float C2 = 1.4426950408889634f * SCALE;
constexpr float THR2 = 8.f * 1.4426950408889634f;
typedef unsigned short bf16;

#define KSWZ(row, colB) ((row) * 256 + ((colB) ^ (((row) & 7) << 4)))
#define SBAR() __builtin_amdgcn_sched_barrier(0)
__device__ __forceinline__ int v_st(int k, int c) { const int kk = (k & ~0xC) | ((k & 4) << 1) | ((k & 8) >> 1); return ((kk >> 3) * 4 + (c >> 5)) * 512 + ((kk & 7) * 32 + (c & 31)) * 2; }
__device__ __forceinline__ int v_rd_base(int lane) { return ((lane & 3) << 3) | (((lane >> 2) & 3) << 6) | (((lane >> 4) & 1) << 5) | (((lane >> 5) & 1) << 8); }
constexpr int v_rd_off(int d0, int ks, int half) { return d0 * 512 + ks * 4096 + half * 2048; }
__device__ __forceinline__ int crow(int r, int hi) { return (r & 3) + 8 * (r >> 2) + 4 * hi; }
__device__ __forceinline__ unsigned cvtpk(float lo, float hi) { unsigned r; asm volatile("v_cvt_pk_bf16_f32 %0, %1, %2" : "=v"(r) : "v"(lo), "v"(hi)); return r; }
__device__ __forceinline__ bf16x8 load8(const bf16* p) { return *reinterpret_cast<const bf16x8*>(p); }
__device__ __forceinline__ void mask_tile(f32x16& p0, f32x16& p1, int dq, unsigned W) {
    const float NEG = -__builtin_inff();
#pragma unroll
    for (int r = 0; r < 16; ++r) {
        const int c = (r & 3) + 8 * (r >> 2);
        if ((unsigned)(dq - c) >= W) p0[r] = NEG;
        if ((unsigned)(dq - c - 32) >= W) p1[r] = NEG;
    }
}
__device__ __forceinline__ void partialSM(f32x16& p0, f32x16& p1, float& m_reg, float& mn, float& alpha, float cq) {
    float pmax = p0[0]; for (int r = 1; r < 16; ++r) pmax = fmaxf(pmax, p0[r]); for (int r = 0; r < 16; ++r) pmax = fmaxf(pmax, p1[r]);
    { auto rr = __builtin_amdgcn_permlane32_swap(__float_as_uint(pmax), __float_as_uint(pmax), false, false);
      pmax = fmaxf(__uint_as_float(rr[0]), __uint_as_float(rr[1])); }
    const float tmax = fmaf(pmax, C2, cq);
    if (__builtin_expect(__all((tmax - m_reg) <= THR2), 1)) { mn = m_reg; alpha = 1.f; }
    else { mn = fmaxf(m_reg, tmax); alpha = __builtin_amdgcn_exp2f(m_reg - mn); m_reg = mn; }
    const float mnL = cq - mn;
    for (int r = 0; r < 16; ++r) p0[r] = fmaf(p0[r], C2, mnL); for (int r = 0; r < 16; ++r) p1[r] = fmaf(p1[r], C2, mnL);
    for (int r = 0; r < 16; ++r) p0[r] = __builtin_amdgcn_exp2f(p0[r]);
}
__device__ __forceinline__ void finishSM(f32x16& p0, f32x16& p1, float alpha, float& l_reg, bf16x8& pa0, bf16x8& pa1, bf16x8& pa2, bf16x8& pa3) {
#pragma unroll
    for (int r = 0; r < 16; ++r) p1[r] = __builtin_amdgcn_exp2f(p1[r]);
    float ps = 0;
#pragma unroll
    for (int r = 0; r < 16; ++r) ps += p0[r];
#pragma unroll
    for (int r = 0; r < 16; ++r) ps += p1[r];
    { auto rr = __builtin_amdgcn_permlane32_swap(__float_as_uint(ps), __float_as_uint(ps), false, false);
      ps = __uint_as_float(rr[0]) + __uint_as_float(rr[1]); }
    l_reg = l_reg * alpha + ps;
#define PK4(P, B_, OUT) do { unsigned a0 = cvtpk(P[B_+0], P[B_+1]), a1 = cvtpk(P[B_+2], P[B_+3]);                          \
        unsigned b0 = cvtpk(P[B_+4], P[B_+5]), b1 = cvtpk(P[B_+6], P[B_+7]);                                             \
        auto r0 = __builtin_amdgcn_permlane32_swap(a0, b0, false, false); auto r1 = __builtin_amdgcn_permlane32_swap(a1, b1, false, false); \
        u32x4 w = {r0[0], r1[0], r0[1], r1[1]}; OUT = *reinterpret_cast<bf16x8*>(&w); } while (0)
    PK4(p0, 0, pa0); PK4(p0, 8, pa1); PK4(p1, 0, pa2); PK4(p1, 8, pa3);
#undef PK4
}
template <int KB, bool FOX>
__device__ __forceinline__ void qkt(f32x16& p0, f32x16& p1, const char* K_lds, int r32, int hi, const bf16x8* qr, const LAS float* nclp) {
    if constexpr (FOX) {
#pragma unroll
        for (int g = 0; g < 4; ++g) { const f32x4 n0 = *(const LAS f32x4*)(nclp + 8 * g), n1 = *(const LAS f32x4*)(nclp + 32 + 8 * g);
#pragma unroll
            for (int e = 0; e < 4; ++e) { p0[4 * g + e] = n0[e]; p1[4 * g + e] = n1[e]; } }
    } else { p0 = f32x16{}; p1 = f32x16{}; }
    const char* kb[4];
#pragma unroll
    for (int dd = 0; dd < 4; ++dd) kb[dd] = K_lds + KB * SHM_K + KSWZ(r32, (dd * 16 + hi * 8) * 2);
#pragma unroll
    for (int d0 = 0; d0 < 8; ++d0) { const char* a = kb[d0 & 3] + (d0 >> 2) * 128;
        bf16x8 b0 = *reinterpret_cast<const bf16x8*>(a);
        bf16x8 b1 = *reinterpret_cast<const bf16x8*>(a + 32 * 256);
        p0 = __builtin_amdgcn_mfma_f32_32x32x16_bf16(b0, qr[d0], p0, 0, 0, 0);
        p1 = __builtin_amdgcn_mfma_f32_32x32x16_bf16(b1, qr[d0], p1, 0, 0, 0); }
}
template <int VB>
__device__ __forceinline__ void pv_tile(f32x16* o, int vb0, bf16x8 pa0, bf16x8 pa1, bf16x8 pa2, bf16x8 pa3) {
#define TRRD(dst, off) asm volatile("ds_read_b64_tr_b16 %0, %1 offset:%2" : "=&v"(dst) : "v"(vb0), "i"(off) : "memory")
#define PV_D0(d0) do { s16x4 l0, l1, l2, l3, h0, h1, h2, h3; constexpr int b_ = VB * SHM_V + v_rd_off(d0, 0, 0); \
        TRRD(l0, b_); TRRD(h0, b_ + 2048); TRRD(l1, b_ + 4096); TRRD(h1, b_ + 6144); TRRD(l2, b_ + 8192); TRRD(h2, b_ + 10240); TRRD(l3, b_ + 12288); TRRD(h3, b_ + 14336); \
        asm volatile("s_waitcnt lgkmcnt(0)" ::: "memory"); SBAR();   \
        o[d0] = __builtin_amdgcn_mfma_f32_32x32x16_bf16(pa0, (bf16x8){l0[0], l0[1], l0[2], l0[3], h0[0], h0[1], h0[2], h0[3]}, o[d0], 0, 0, 0);   \
        o[d0] = __builtin_amdgcn_mfma_f32_32x32x16_bf16(pa1, (bf16x8){l1[0], l1[1], l1[2], l1[3], h1[0], h1[1], h1[2], h1[3]}, o[d0], 0, 0, 0);   \
        o[d0] = __builtin_amdgcn_mfma_f32_32x32x16_bf16(pa2, (bf16x8){l2[0], l2[1], l2[2], l2[3], h2[0], h2[1], h2[2], h2[3]}, o[d0], 0, 0, 0);   \
        o[d0] = __builtin_amdgcn_mfma_f32_32x32x16_bf16(pa3, (bf16x8){l3[0], l3[1], l3[2], l3[3], h3[0], h3[1], h3[2], h3[3]}, o[d0], 0, 0, 0); } while (0)
    PV_D0(0); PV_D0(1); PV_D0(2); PV_D0(3);
#undef PV_D0
#undef TRRD
}

struct BlockRef { const bf16* Q; const bf16* K; const bf16* V; bf16* O; const float* CL; int P0; int jlo; const bf16* Q2; float* GS; };
struct Seam { bf16x8 qr[8]; bf16x8 st_v0, st_v1, st_k0, st_k1; };
#define ROWK(p, k0, rr) ((p) + (size_t)((k0) + (rr)) * LDK + sc)
#define VMW() asm volatile("s_waitcnt vmcnt(0)" ::: "memory")
#define VMWN(n) asm volatile("s_waitcnt vmcnt(%0)" :: "i"(n) : "memory")
#define SLOAD_H(Kp, Vp, k0) do { S.st_v0 = load8(ROWK(Vp, k0, sr)); S.st_v1 = load8(ROWK(Vp, k0, 32 + sr));              \
                         S.st_k0 = load8(ROWK(Kp, k0, sr)); S.st_k1 = load8(ROWK(Kp, k0, 32 + sr)); } while (0)
#define SWRITE_HK(bf) do { *(bf16x8*)(K_lds + (bf) * SHM_K + kws) = S.st_k0; *(bf16x8*)(K_lds + (bf) * SHM_K + kws + 32 * 256) = S.st_k1; } while (0)
#define SWRITE_HV(bf) do { *(bf16x8*)(V_lds + (bf) * SHM_V + vst0) = S.st_v0; *(bf16x8*)(V_lds + (bf) * SHM_V + vst1) = S.st_v1; } while (0)
#define SWRITE_H(bf) do { SWRITE_HV(bf); SWRITE_HK(bf); } while (0)
__device__ __forceinline__ bf16x8 add8(bf16x8 a, bf16x8 b) {
    const u32x4 x = *reinterpret_cast<const u32x4*>(&a), y = *reinterpret_cast<const u32x4*>(&b); u32x4 w;
#pragma unroll
    for (int i = 0; i < 4; ++i) w[i] = cvtpk(__uint_as_float(x[i] << 16) + __uint_as_float(y[i] << 16), __uint_as_float(x[i] & 0xffff0000u) + __uint_as_float(y[i] & 0xffff0000u));
    return *reinterpret_cast<bf16x8*>(&w);
}
template <int LDQ, int LDK, bool QSUM = false>
__device__ __forceinline__ void attn_prime(const BlockRef& cur, char* lds, Seam& S) {
    const int tid = opaque_tid(), wid = __builtin_amdgcn_readfirstlane(tid >> 6), lane = tid & 63, r32 = lane & 31, hi = lane >> 5;
    const int sr = tid >> 4, sc = (tid & 15) * 8, kws = KSWZ(sr, sc * 2); char* K_lds = lds + 2 * SHM_V;
    const int kb0 = cur.jlo * KVBLK;
#pragma unroll
    for (int d0 = 0; d0 < 8; ++d0) { S.qr[d0] = load8(cur.Q + (size_t)(wid * QBLK + r32) * LDQ + d0 * 16 + hi * 8);
        if constexpr (QSUM) S.qr[d0] = add8(S.qr[d0], load8(cur.Q2 + (size_t)(wid * QBLK + r32) * LDQ + d0 * 16 + hi * 8)); }
    SLOAD_H(cur.K, cur.V, kb0); VMW(); SWRITE_HK(0);
    __syncthreads();
}
template <bool FOX, int LDQ, int LDK, int LDO>
__device__ __forceinline__ void attn_block(const BlockRef& cur, const BlockRef& nxt, int skv, unsigned W, char* lds, LAS float* clds, Seam& S) {
    const int tid = opaque_tid(), wid = __builtin_amdgcn_readfirstlane(tid >> 6), lane = tid & 63, r32 = lane & 31, hi = lane >> 5;
    const int j_lo = cur.jlo;
    int j_hi = (cur.P0 + QB - 1) / KVBLK + 1; if (j_hi > skv / KVBLK) j_hi = skv / KVBLK;
    const int NT = j_hi - j_lo;
    const int kbn = nxt.jlo * KVBLK;
    const int qlo = cur.P0 + wid * QBLK, qm = qlo + r32 - 4 * hi;
    char* V_lds = lds; char* K_lds = lds + 2 * SHM_V;
    float* ws = (float*)(lds + 2 * SHM_V + 2 * SHM_K) + wid * 64; float* li_l = ws, * al_l = ws + 32;
    float m_reg = -1e30f, l_reg = 0; f32x16 o[4] = {};
    const int sr = tid >> 4, sc = (tid & 15) * 8, vst0 = v_st(sr, sc), vst1 = v_st(32 + sr, sc), kws = KSWZ(sr, sc * 2);
    const int vb0 = (int)(uintptr_t)V_lds + v_rd_base(lane);
    float cq = 0.f; const LAS float* nclb = clds + 4 * hi;
    if constexpr (FOX) {
        const float cref = cur.CL[cur.P0];
        for (int i = j_lo * KVBLK + tid * 4; i < cur.P0 + QB; i += 2048) { const f32x4 v = *(const f32x4*)(cur.CL + i); *(LAS f32x4*)(clds + i) = (cref - v) * (1.0f / C2); }
        cq = cur.CL[qlo + r32] - cref;
    }
    const bf16* Kh = cur.K; const bf16* Vh = cur.V;
#define RESC(a) do { if (__any((a) < 1.f)) { if (hi == 0) al_l[r32] = (a); asm volatile("s_waitcnt lgkmcnt(0)" ::: "memory");              \
                     for (int d_ = 0; d_ < 4; ++d_) for (int r = 0; r < 16; ++r) o[d_][r] *= al_l[crow(r, hi)]; } } while (0)
#define KBASE(t) ((j_lo + (t)) * KVBLK)
#define MASKT(P0_, P1_, t) do { const int kb_ = KBASE(t); if (kb_ + KVBLK - 1 > qlo || kb_ <= qlo + QBLK - 1 - (int)W) mask_tile(P0_, P1_, qm - kb_, W); } while (0)
    f32x16 pX0, pX1; float mnX, alX; bf16x8 pa0, pa1, pa2, pa3;
    SWRITE_HV(0); SBAR();
    if (NT > 1) { SLOAD_H(Kh, Vh, KBASE(1)); }
    __syncthreads();
#define TILE_STEP(t, B) do {                                                                                      \
        SBAR(); qkt<B, FOX>(pX0, pX1, K_lds, r32, hi, S.qr, nclb + KBASE(t)); SBAR();                             \
        if ((t) + 1 < NT) { VMW(); SWRITE_H((B) ^ 1); SBAR(); if ((t) + 2 < NT) { SLOAD_H(Kh, Vh, KBASE((t) + 2)); } SBAR(); } \
        MASKT(pX0, pX1, (t)); partialSM(pX0, pX1, m_reg, mnX, alX, cq); RESC(alX);                                \
        finishSM(pX0, pX1, alX, l_reg, pa0, pa1, pa2, pa3); SBAR();                                               \
        pv_tile<B>(o, vb0, pa0, pa1, pa2, pa3);                                                                   \
        __syncthreads(); } while (0)
    int t = 0;
    for (; t + 1 < NT; t += 2) { TILE_STEP(t, 0); TILE_STEP(t + 1, 1); }
    if (t < NT) { TILE_STEP(t, 0); }
    SLOAD_H(nxt.K, nxt.V, kbn); SBAR();
#pragma unroll
    for (int d0 = 0; d0 < 8; ++d0) S.qr[d0] = load8(nxt.Q + (size_t)(wid * QBLK + r32) * LDQ + d0 * 16 + hi * 8);
    SBAR();
    if (hi == 0) li_l[r32] = l_reg; asm volatile("s_waitcnt lgkmcnt(0)" ::: "memory");
    float rli[16];
#pragma unroll
    for (int r = 0; r < 16; ++r) rli[r] = __builtin_amdgcn_rcpf(li_l[crow(r, hi)]);
    VMWN(8); SWRITE_HK(0); SBAR();
    bf16* Ow = cur.O + (size_t)(wid * QBLK) * LDO;
#pragma unroll
    for (int r = 0; r < 16; ++r) { const int orow = crow(r, hi);
        float sq = 0.f;
#pragma unroll
        for (int d0 = 0; d0 < 4; ++d0) { const float v = o[d0][r] * rli[r];
            const float vn = __shfl_xor(v, 1);
            sq += v * v;
            if ((r32 & 1) == 0) *(unsigned*)(Ow + (size_t)orow * LDO + d0 * 32 + r32) = cvtpk(v, vn); }
        if constexpr (FOX) {
            sq += __shfl_xor(sq, 1); sq += __shfl_xor(sq, 2); sq += __shfl_xor(sq, 4); sq += __shfl_xor(sq, 8); sq += __shfl_xor(sq, 16);
            if (r32 == 0) cur.GS[(size_t)(wid * QBLK + orow) * 24] = sq; } }
    __syncthreads();
#undef RESC
#undef KBASE
#undef MASKT
#undef TILE_STEP
}
#undef ROWK
#undef VMW
#undef VMWN
#undef SLOAD_H
#undef SWRITE_HK
#undef SWRITE_HV
#undef SWRITE_H
}
#define XB_TMO      128
#define XB_XCNT(j)  (256  + 64 * (j))
#define XB_XSUB(j)  (1280 + 64 * (j))
#define XB_XGEN(j)  (2304 + 64 * (j))
#define XB_TOP      3328
#define XB_TOPGEN   3392
#define XCD_BAR_WORDS 3456
#define XB_SPIN_CAP (1u << 18)

__device__ __forceinline__ unsigned xb_ld(unsigned* p)              { return __hip_atomic_load(p, __ATOMIC_RELAXED, __HIP_MEMORY_SCOPE_AGENT); }
__device__ __forceinline__ unsigned xb_add(unsigned* p, unsigned v) { return __hip_atomic_fetch_add(p, v, __ATOMIC_RELAXED, __HIP_MEMORY_SCOPE_AGENT); }
__device__ __forceinline__ unsigned xb_xcc_id() { return (unsigned)__builtin_amdgcn_s_getreg((3 << 11) | 20) & 0xFu; }
#define XB_SPIN(cond, bar) do { unsigned _sp = 0; while (cond) { __builtin_amdgcn_s_sleep(1); \
    if ((++_sp & 255u) == 0u) { if (xb_ld(&(bar)[XB_TMO])) break; if (_sp > XB_SPIN_CAP) { atomicAdd(&(bar)[XB_TMO], 1u); break; } } } } while (0)

struct XcdBarrier {
    unsigned* bar; unsigned x;
    volatile LAS unsigned* st;
};

__device__ __forceinline__ XcdBarrier xcd_barrier_post(unsigned* bar, volatile LAS unsigned* st) {
    XcdBarrier b; b.bar = bar; b.x = xb_xcc_id(); b.st = st;
    if (threadIdx.x == 0) (void)xb_add(&bar[XB_XCNT(b.x)], 1u);
    return b;
}
__device__ __forceinline__ void xcd_barrier_complete(unsigned* bar, unsigned x, unsigned& nloc, unsigned& nx) {
    const unsigned G = gridDim.x * gridDim.y * gridDim.z;
    unsigned sum, cnt, mine, sp = 0u;
    for (;;) {
        sum = 0u; cnt = 0u; mine = 0u;
#pragma unroll
        for (unsigned j = 0; j < 16; ++j) { const unsigned c = xb_ld(&bar[XB_XCNT(j)]); sum += c; cnt += (c > 0u) ? 1u : 0u; mine = (j == x) ? c : mine; }
        if (sum == G) break;
        __builtin_amdgcn_s_sleep(1);
        if ((++sp & 255u) == 0u) { if (xb_ld(&bar[XB_TMO])) break; if (sp > XB_SPIN_CAP) { atomicAdd(&bar[XB_TMO], 1u); break; } }
    }
    nloc = mine > 0u ? mine : 1u; nx = cnt > 0u ? cnt : 1u;
}

__device__ __forceinline__ void xcd_barrier(const XcdBarrier& b) {
    asm volatile("s_waitcnt vmcnt(0)" ::: "memory");
    __syncthreads();
    if (threadIdx.x == 0) {
        unsigned* bar = b.bar; asm volatile("" : "+s"(bar)); unsigned bx = b.x; asm volatile("" : "+s"(bx));
        __builtin_amdgcn_s_waitcnt(0);
        unsigned nloc = b.st[0], nx = b.st[1];
        if (nloc == 0u) { xcd_barrier_complete(bar, bx, nloc, nx); b.st[0] = nloc; b.st[1] = nx; }
        const unsigned old = xb_add(&bar[XB_XSUB(bx)], 1u);
        const unsigned gen = old / nloc;
        if (old + 1u == (gen + 1u) * nloc) {
            __builtin_amdgcn_fence(__ATOMIC_RELEASE, "agent");
            asm volatile("s_waitcnt vmcnt(0)" ::: "memory");
            const unsigned og = xb_add(&bar[XB_TOP], 1u);
            const unsigned tg = og / nx;
            if (og + 1u == (tg + 1u) * nx) xb_add(&bar[XB_TOPGEN], 1u);
            else XB_SPIN(xb_ld(&bar[XB_TOPGEN]) == tg, bar);
            __builtin_amdgcn_fence(__ATOMIC_ACQUIRE, "agent");
            xb_add(&bar[XB_XGEN(bx)], 1u);
            asm volatile("s_waitcnt vmcnt(0)" ::: "memory");
        } else {
            XB_SPIN(xb_ld(&bar[XB_XGEN(bx)]) == gen, bar);
            __builtin_amdgcn_fence(__ATOMIC_ACQUIRE, "agent");
            asm volatile("s_waitcnt vmcnt(0)" ::: "memory");
        }
    }
    __syncthreads();
}


#ifndef MK_PER_PHASE
#define MK_PER_PHASE 0
#endif
constexpr int S = 16384, DM = 2048, DFF = 5632, PIN = 4612, NZ = 4608, NZP = 4864, NMEM = 256, NLAYER = 2;
constexpr float EPS = 1e-6f;
constexpr float LOG2E = 1.4426950408889634f;
constexpr size_t MiB = 1u << 20;
constexpr size_t WS_CTL = 0;
constexpr size_t WS_BAR = 64 * 1024;
constexpr size_t WS_WF = 1 * MiB;
constexpr size_t WS_FL = 1 * MiB + 256 * 1024;
constexpr size_t WS_CL = 1 * MiB + 512 * 1024;
constexpr size_t WS_RSA = 680 * MiB, WS_RSB = 684 * MiB;
constexpr size_t WS_MEMN = 3 * MiB;
constexpr size_t WS_KVX = 5 * MiB;
constexpr size_t WS_XB = 6 * MiB;
constexpr size_t WS_HID = 70 * MiB;
constexpr size_t WS_Z = WS_HID, WS_PC = WS_HID + 144 * MiB;
constexpr size_t WS_Y = 246 * MiB;
constexpr size_t WS_QX = 310 * MiB, WS_OX = 326 * MiB;
constexpr size_t WS_GSP = 706 * MiB;
constexpr size_t WS_QX2 = 688 * MiB;
constexpr size_t WS_W = 342 * MiB;
constexpr size_t OW_GU1 = 0, OW_D1 = OW_GU1 + (size_t)2 * DFF * DM, OW_MI = OW_D1 + (size_t)DM * DFF, OW_PP = OW_MI + (size_t)NZP * DM, OW_MO = OW_PP + 1024 * 512,
                 OW_XQ = OW_MO + (size_t)DM * DM, OW_XKV = OW_XQ + 512 * DM, OW_XO = OW_XKV + 1024 * DM, OW_GU2 = OW_XO + DM * 512, OW_D2 = OW_GU2 + (size_t)2 * DFF * DM,
                 LAYER_W = OW_D2 + (size_t)DM * DFF;
constexpr size_t WS_END = WS_W + 2 * LAYER_W * 2;
static_assert(WS_END <= WS_RSA && WS_RSB + 2 * MiB <= 790 * MiB, "ws map");
constexpr size_t WS_NEED = 790 * MiB;
constexpr int LDS_BYTES = 147456;
constexpr int NPH = 1 + 16 * NLAYER;
#ifndef PH_MASK
#define PH_MASK 0x1ffff
#endif
#define PH_EN(k) (((PH_MASK) >> (k)) & 1)

typedef unsigned short bf16;
__device__ __forceinline__ float bf2f(bf16 b) { return __uint_as_float(((unsigned)b) << 16); }
__device__ __forceinline__ unsigned f2bf(float f) { unsigned u = __builtin_bit_cast(unsigned, f); return (u + 0x7fffu + ((u >> 16) & 1u)) >> 16; }
__device__ __forceinline__ unsigned pk2(float lo, float hi) { return f2bf(lo) | (f2bf(hi) << 16); }
#define LDS_WAIT() asm volatile("s_waitcnt lgkmcnt(0)" ::: "memory")
__device__ __forceinline__ float wave_sum(float v) {
#pragma unroll
    for (int o = 1; o < 64; o <<= 1) v += __shfl_xor(v, o);
    return v;
}
__device__ __forceinline__ float sigmoid_f(float g) { return __builtin_amdgcn_rcpf(1.0f + __builtin_amdgcn_exp2f(-LOG2E * g)); }

__device__ __forceinline__ void tr_item(const float* W, int ldw, int src_col0, int k0, bf16* WT, int K, int dst_row0, const float* ksc, LAS float* scr, int lane) {
    float v[32];
    const float* wp = W + (size_t)(k0 + (lane >> 5)) * ldw + src_col0 + (lane & 31);
#pragma unroll
    for (int i = 0; i < 32; ++i) v[i] = wp[(size_t)(2 * i) * ldw];
    if (ksc) {
        const float* kp = ksc + k0 + (lane >> 5);
#pragma unroll
        for (int i = 0; i < 32; ++i) v[i] *= kp[2 * i];
    }
#pragma unroll
    for (int i = 0; i < 32; ++i) scr[(2 * i + (lane >> 5)) * 33 + (lane & 31)] = v[i];
    LDS_WAIT(); asm volatile("" ::: "memory");
    const int c = lane & 7;
#pragma unroll
    for (int j = 0; j < 4; ++j) { const int n = (lane >> 3) + 8 * j; const LAS float* s = scr + (8 * c) * 33 + n;
        u32x4 o; o.x = pk2(s[0 * 33], s[1 * 33]); o.y = pk2(s[2 * 33], s[3 * 33]); o.z = pk2(s[4 * 33], s[5 * 33]); o.w = pk2(s[6 * 33], s[7 * 33]);
        *(u32x4*)(WT + (size_t)(dst_row0 + n) * K + k0 + 8 * c) = o; }
    LDS_WAIT(); asm volatile("" ::: "memory");
}
__device__ __forceinline__ void tr_job(int r, const float* W, int ldw, int K, int Ndst, bf16* WT, int row_off, const float* ksc, int cmode, LAS float* scr, int lane) {
    const int nblk = Ndst / 32, kb = r / nblk, nb = r % nblk, n0 = 32 * nb;
    int src = n0, dst = row_off + n0;
    if (cmode == 1) dst = 256 * (n0 >> 7) + (n0 & 127);
    else if (cmode == 2) dst = 256 * (n0 >> 7) + 128 + (n0 & 127);
    else if (cmode == 3) { src = n0 + (n0 >= 3072 ? 4 : 0);
        if (n0 >= 512 && n0 < 1024) dst = row_off + 512 + 256 * ((n0 - 512) >> 7) + ((n0 - 512) & 127);
        else if (n0 >= 1024 && n0 < 1536) dst = row_off + 512 + 256 * ((n0 - 1024) >> 7) + 128 + ((n0 - 1024) & 127);
        else if (n0 >= 3584 && n0 < 4096) dst = row_off + 3584 + 256 * ((n0 - 3584) >> 7) + ((n0 - 3584) & 127);
        else if (n0 >= 4096 && n0 < 4608) dst = row_off + 3584 + 256 * ((n0 - 4096) >> 7) + 128 + ((n0 - 4096) & 127); }
    tr_item(W, ldw, src, 64 * kb, WT, K, dst, ksc, scr, lane);
}

template <int MODE>
__device__ __forceinline__ void norm_rows(const float* X, bf16* XB, const float* gain, float* OUT, const float* WF, float* FL, int nrows, int gw, int NGW, int lane) {
    f32x4 gv[8];
    if (MODE == 2) {
#pragma unroll
        for (int j = 0; j < 8; ++j) gv[j] = ((const f32x4*)gain + lane)[64 * j];
    }
    for (int row = gw; row < nrows; row += NGW) {
        const f32x4* xr = (const f32x4*)(X + (size_t)row * DM) + lane;
        f32x4 v[8]; float ss = 0.f;
#pragma unroll
        for (int j = 0; j < 8; ++j) v[j] = xr[64 * j];
        __builtin_amdgcn_sched_barrier(0);
#pragma unroll
        for (int j = 0; j < 8; ++j) ss += (v[j].x * v[j].x + v[j].y * v[j].y) + (v[j].z * v[j].z + v[j].w * v[j].w);
        const float sst = wave_sum(ss); const float rstd = MODE == 3 ? 1.0f : 1.0f / sqrtf(sst * (1.0f / DM) + EPS);
        if (MODE == 3 && lane < 32) OUT[(size_t)row * 32 + lane] = lane == 0 ? sst : 0.f;
        if (MODE == 2) {
            f32x4* orow = (f32x4*)(OUT + (size_t)row * DM) + lane;
#pragma unroll
            for (int j = 0; j < 8; ++j) orow[64 * j] = v[j] * rstd * gv[j];
        } else {
            unsigned long long* o8 = (unsigned long long*)(XB + (size_t)row * DM) + lane;
#pragma unroll
            for (int j = 0; j < 8; ++j) o8[64 * j] = (unsigned long long)pk2(v[j].x * rstd, v[j].y * rstd) | ((unsigned long long)pk2(v[j].z * rstd, v[j].w * rstd) << 32);
            if (MODE == 1) {
#pragma unroll
                for (int h = 0; h < 4; ++h) { const f32x4* wr = (const f32x4*)(WF + h * DM) + lane; float d = 0.f;
#pragma unroll
                    for (int j = 0; j < 8; ++j) { const f32x4 w = wr[64 * j]; d += (v[j].x * w.x + v[j].y * w.y) + (v[j].z * w.z + v[j].w * w.w); }
                    d = wave_sum(d); if (lane == 0) FL[row * 4 + h] = d * rstd; }
            }
        }
    }
}
__device__ __forceinline__ void split_rows(const float* X, bf16* XH, float* RSP, int gw, int NGW, int lane) {
    for (int row = gw; row < S; row += NGW) {
        const f32x4* xr = (const f32x4*)(X + (size_t)row * DM) + lane;
        f32x4 v[8]; float ss = 0.f;
#pragma unroll
        for (int j = 0; j < 8; ++j) v[j] = xr[64 * j];
        __builtin_amdgcn_sched_barrier(0);
        unsigned long long* oh = (unsigned long long*)(XH + (size_t)row * DM) + lane;
#pragma unroll
        for (int j = 0; j < 8; ++j) { ss += (v[j].x * v[j].x + v[j].y * v[j].y) + (v[j].z * v[j].z + v[j].w * v[j].w);
            const unsigned h0 = pk2(v[j].x, v[j].y), h1 = pk2(v[j].z, v[j].w);
            oh[64 * j] = (unsigned long long)h0 | ((unsigned long long)h1 << 32); }
        const float sst = wave_sum(ss);
        if (lane < 32) RSP[(size_t)row * 32 + lane] = lane == 0 ? sst : 0.f;
    }
}
__device__ __forceinline__ void final_rows(const bf16* XH, const float* RSP, const float* gain, float* OUT, int gw, int NGW, int lane) {
    f32x4 gv[4][2];
#pragma unroll
    for (int j = 0; j < 4; ++j) { gv[j][0] = *(const f32x4*)(gain + 8 * (lane + 64 * j)); gv[j][1] = *(const f32x4*)(gain + 8 * (lane + 64 * j) + 4); }
    for (int row = gw; row < S; row += NGW) {
        const u32x4* xh = (const u32x4*)(XH + (size_t)row * DM) + lane;
        u32x4 wh[4];
#pragma unroll
        for (int j = 0; j < 4; ++j) wh[j] = xh[64 * j];
        const float p = RSP[(size_t)row * 32 + (lane & 31)];
        __builtin_amdgcn_sched_barrier(0);
        const float rstd = 1.0f / sqrtf(wave_sum(lane < 32 ? p : 0.f) * (1.0f / DM) + EPS);
        float* orow = OUT + (size_t)row * DM;
#pragma unroll
        for (int j = 0; j < 4; ++j) { const u32x4 q = wh[j];
            f32x4 a = {__uint_as_float(q.x << 16), __uint_as_float(q.x & 0xffff0000u), __uint_as_float(q.y << 16), __uint_as_float(q.y & 0xffff0000u)};
            f32x4 b = {__uint_as_float(q.z << 16), __uint_as_float(q.z & 0xffff0000u), __uint_as_float(q.w << 16), __uint_as_float(q.w & 0xffff0000u)};
            *(f32x4*)(orow + 8 * (lane + 64 * j)) = a * rstd * gv[j][0]; *(f32x4*)(orow + 8 * (lane + 64 * j) + 4) = b * rstd * gv[j][1]; }
    }
}
__device__ __forceinline__ void group_norm_rows(bf16* Y, int gw, int NGW, int lane) {
    for (int row = gw; row < S; row += 2 * NGW) {
        u32x4* yr0 = (u32x4*)(Y + (size_t)row * DM) + lane; u32x4* yr1 = (u32x4*)(Y + (size_t)(row + NGW) * DM) + lane;
        u32x4 w[2][3];
#pragma unroll
        for (int g = 0; g < 3; ++g) { w[0][g] = yr0[64 * g]; w[1][g] = yr1[64 * g]; }
        __builtin_amdgcn_sched_barrier(0);
#pragma unroll
        for (int r = 0; r < 2; ++r)
#pragma unroll
            for (int g = 0; g < 3; ++g) { const u32x4 q = w[r][g]; float f[8];
                f[0] = __uint_as_float(q.x << 16); f[1] = __uint_as_float(q.x & 0xffff0000u); f[2] = __uint_as_float(q.y << 16); f[3] = __uint_as_float(q.y & 0xffff0000u);
                f[4] = __uint_as_float(q.z << 16); f[5] = __uint_as_float(q.z & 0xffff0000u); f[6] = __uint_as_float(q.w << 16); f[7] = __uint_as_float(q.w & 0xffff0000u);
                float ss = 0.f;
#pragma unroll
                for (int e = 0; e < 8; ++e) ss += f[e] * f[e];
                const float rstd = 1.0f / sqrtf(wave_sum(ss) * (1.0f / 512.0f) + EPS);
                u32x4 o; o.x = pk2(f[0] * rstd, f[1] * rstd); o.y = pk2(f[2] * rstd, f[3] * rstd); o.z = pk2(f[4] * rstd, f[5] * rstd); o.w = pk2(f[6] * rstd, f[7] * rstd);
                (r ? yr1 : yr0)[64 * g] = o; }
    }
}

template <int PM>
__device__ __forceinline__ void ew_post(LAS float* buf, bf16* dst, int ld, const float* lg, const float* lb, int wid, int lane) {
    f32x4 g0 = {1, 1, 1, 1}, g1 = g0, b0 = {0, 0, 0, 0}, b1 = b0;
    if (PM == 1) { g0 = *(const f32x4*)(lg + 8 * lane); g1 = *(const f32x4*)(lg + 8 * lane + 4); b0 = *(const f32x4*)(lb + 8 * lane); b1 = *(const f32x4*)(lb + 8 * lane + 4); }
#pragma unroll
    for (int q = 0; q < 4; ++q) { const int i = wid * 4 + q;
        f32x4 v0 = *(const LAS f32x4*)(buf + i * 512 + 8 * lane), v1 = *(const LAS f32x4*)(buf + i * 512 + 8 * lane + 4);
        if (PM == 1) {
            const float mean = wave_sum((v0.x + v0.y) + (v0.z + v0.w) + (v1.x + v1.y) + (v1.z + v1.w)) * (1.0f / 512.0f);
            v0 = v0 - mean; v1 = v1 - mean;
            const float var = wave_sum((v0.x * v0.x + v0.y * v0.y) + (v0.z * v0.z + v0.w * v0.w) + (v1.x * v1.x + v1.y * v1.y) + (v1.z * v1.z + v1.w * v1.w)) * (1.0f / 512.0f);
            const float rstd = 1.0f / sqrtf(var + EPS);
            v0 = v0 * rstd * g0 + b0; v1 = v1 * rstd * g1 + b1;
            v0.x *= sigmoid_f(v0.x); v0.y *= sigmoid_f(v0.y); v0.z *= sigmoid_f(v0.z); v0.w *= sigmoid_f(v0.w);
            v1.x *= sigmoid_f(v1.x); v1.y *= sigmoid_f(v1.y); v1.z *= sigmoid_f(v1.z); v1.w *= sigmoid_f(v1.w);
        } else if (PM == 2) {
            const float ss = wave_sum((v0.x * v0.x + v0.y * v0.y) + (v0.z * v0.z + v0.w * v0.w) + (v1.x * v1.x + v1.y * v1.y) + (v1.z * v1.z + v1.w * v1.w)) * (1.0f / 512.0f);
            const float rstd = 1.0f / sqrtf(ss + EPS);
            v0 = v0 * rstd; v1 = v1 * rstd;
        }
        u32x4 o; o.x = pk2(v0.x, v0.y); o.y = pk2(v0.z, v0.w); o.z = pk2(v1.x, v1.y); o.w = pk2(v1.z, v1.w);
        *(u32x4*)(dst + (size_t)i * ld + 8 * lane) = o; }
}
template <int NC, int NIT>
__device__ __forceinline__ void ew_stage(const bf16* Z, int col0, int row_first, int nrows, LAS unsigned char* stg, int tid) {
    constexpr int CPR = NC / 8;
    u32x4 v[NIT];
#pragma unroll
    for (int it = 0; it < NIT; ++it) { int c = tid + it * 512; if (c >= nrows * CPR) c = nrows * CPR - 1; const int r = c / CPR, cc = c % CPR; int tt = row_first + r; tt = tt < 0 ? 0 : tt;
        v[it] = *(const u32x4*)(Z + (size_t)tt * NZ + col0 + cc * 8); }
    __builtin_amdgcn_sched_barrier(0);
#pragma unroll
    for (int it = 0; it < NIT; ++it) { int c = tid + it * 512; if (c >= nrows * CPR) c = nrows * CPR - 1;
        *(LAS u32x4*)(stg + (size_t)c * 16) = v[it]; }
}
__device__ __forceinline__ void ew_chunk(const bf16* Z, bf16* PC, bf16* Y, const float* dw_w, const float* dw_b, const float* ln_g, const float* ln_b, const float* sc_w,
                                         float* NRM, LAS float* buf, int chunk, int tid, int wid, int lane) {
    const int t0 = chunk * 32, ch = tid;
    LAS unsigned char* stg = (LAS unsigned char*)buf + 65536; const LAS bf16* st16 = (const LAS bf16*)stg;
    {
        const int p = tid >> 1, isK = p >> 7, tok = (p >> 2) & 31, hd = p & 3;
        const bf16* src = Z + (size_t)(t0 + tok) * NZ + 1536 + isK * 512 + hd * 128 + (tid & 1) * 64;
        u32x4 w8[8];
#pragma unroll
        for (int c = 0; c < 8; ++c) w8[c] = *(const u32x4*)(src + 8 * c);
        __builtin_amdgcn_sched_barrier(0);
        float ss = 0.f;
#pragma unroll
        for (int c = 0; c < 8; ++c) { const u32x4 w = w8[c];
            const float f0 = __uint_as_float(w.x << 16), f1 = __uint_as_float(w.x & 0xffff0000u), f2 = __uint_as_float(w.y << 16), f3 = __uint_as_float(w.y & 0xffff0000u);
            const float f4 = __uint_as_float(w.z << 16), f5 = __uint_as_float(w.z & 0xffff0000u), f6 = __uint_as_float(w.w << 16), f7 = __uint_as_float(w.w & 0xffff0000u);
            ss += (f0 * f0 + f1 * f1) + (f2 * f2 + f3 * f3) + (f4 * f4 + f5 * f5) + (f6 * f6 + f7 * f7); }
        ss += __shfl_xor(ss, 1);
        ss = fmaxf(ss, __shfl_xor(ss, 8)); ss = fmaxf(ss, __shfl_xor(ss, 16)); ss = fmaxf(ss, __shfl_xor(ss, 32));
        if (lane < 8 && !(lane & 1)) NRM[(isK * 4 + hd) * 2048 + chunk * 4 + (wid & 3)] = ss;
    }
    {
        float seq[62];
        ew_stage<512, 8>(Z, 512, t0 - 30, 62, stg, tid);
        __syncthreads();
#pragma unroll
        for (int i = 0; i < 62; ++i) { const int tt = t0 - 30 + i; seq[i] = (tt < 0 ? 0.f : 1.f) * bf2f(st16[i * 512 + ch]); }
        __syncthreads();
        float cv[32], wk[31]; const float b = dw_b[ch];
#pragma unroll
        for (int k = 0; k < 31; ++k) wk[k] = dw_w[k * 512 + ch];
        __builtin_amdgcn_sched_barrier(0);
#pragma unroll
        for (int i = 0; i < 32; ++i) cv[i] = b;
#pragma unroll
        for (int k = 0; k < 31; ++k) {
#pragma unroll
            for (int i = 0; i < 32; ++i) cv[i] = fmaf(wk[k], seq[i + k], cv[i]); }
#pragma unroll
        for (int i = 0; i < 32; ++i) buf[i * 512 + ch] = cv[i];
    }
    __syncthreads();
    ew_post<1>(buf, PC + (size_t)(S + t0) * 512, 512, ln_g, ln_b, wid, lane);
    {
        float m[34];
        ew_stage<512, 5>(Z, 3584, t0 - 2, 34, stg, tid);
        __syncthreads();
#pragma unroll
        for (int i = 0; i < 34; ++i) { const int tt = t0 - 2 + i; m[i] = (tt < 0 ? 0.f : 1.f) * bf2f(st16[i * 512 + ch]); }
        __syncthreads();
        ew_stage<512, 4>(Z, 3072, t0, 32, stg, tid);
        __syncthreads();
        const float w0 = sc_w[ch], w1 = sc_w[512 + ch], w2 = sc_w[1024 + ch];
#pragma unroll
        for (int i = 0; i < 32; ++i) buf[i * 512 + ch] = bf2f(st16[i * 512 + ch]) * (w0 * m[i] + w1 * m[i + 1] + w2 * m[i + 2]);
    }
    __syncthreads();
    ew_post<2>(buf, Y + (size_t)t0 * DM + 1536, DM, nullptr, nullptr, wid, lane);
    {
        float seq[47];
        ew_stage<512, 6>(Z, 0, t0 - 15, 47, stg, tid);
        __syncthreads();
#pragma unroll
        for (int i = 0; i < 47; ++i) { const int tt = t0 - 15 + i; seq[i] = (tt < 0 ? 0.f : 1.f) * bf2f(st16[i * 512 + ch]); }
        const int w = 2 << (wid >> 1);
#pragma unroll
        for (int i = 0; i < 32; ++i) { float s = 0.f;
#pragma unroll
            for (int j = 0; j < 16; ++j) s += (j < w) ? seq[15 + i - j] : 0.f;
            const int cnt = (t0 + i + 1) < w ? (t0 + i + 1) : w;
            buf[i * 512 + ch] = s / (float)cnt - seq[15 + i]; }
    }
    __syncthreads();
    ew_post<0>(buf, PC + (size_t)t0 * 512, 512, nullptr, nullptr, wid, lane);
    __syncthreads();
}
__device__ __forceinline__ void scan_head(const float* FL, float bias, float* CLh, int h, LAS unsigned char* lds, int tid) {
    LAS float* sl = (LAS float*)lds;
    LAS double* sd = (LAS double*)(lds + 67584);
    float ls[32];
#pragma unroll
    for (int i = 0; i < 32; ++i) ls[i] = FL[(size_t)(i * 512 + tid) * 4 + h];
    __builtin_amdgcn_sched_barrier(0);
#pragma unroll
    for (int i = 0; i < 32; ++i) { const int e = i * 512 + tid; const float x = ls[i] + bias; const float ex = __builtin_amdgcn_exp2f(-fabsf(x) * LOG2E);
        sl[e + (e >> 5)] = (fminf(x, 0.f) - log1pf(ex)) * LOG2E; }
    __syncthreads();
    double s = 0.0;
#pragma unroll
    for (int i = 0; i < 32; ++i) { ls[i] = sl[tid * 33 + i]; s += (double)ls[i]; }
    sd[tid] = s; __syncthreads();
    for (int off = 1; off < 512; off <<= 1) { const double v = tid >= off ? sd[tid - off] : 0.0; __syncthreads(); sd[tid] += v; __syncthreads(); }
    double run = tid ? sd[tid - 1] : 0.0;
#pragma unroll
    for (int i = 0; i < 32; ++i) { run += (double)ls[i]; sl[tid * 33 + i] = (float)run; }
    __syncthreads();
#pragma unroll
    for (int i = 0; i < 32; ++i) { const int e = i * 512 + tid; CLh[e] = sl[e + (e >> 5)]; }
    __syncthreads();
}

__device__ __forceinline__ att::BlockRef fox_block(const bf16* Z, bf16* Y, const float* CL, float* GSP, int h, int x, int jlo) {
    att::BlockRef b; b.Q = Z + (size_t)(x * 256) * NZ + 1536 + h * 128; b.K = Z + 2048 + h * 128; b.V = Z + 2560 + h * 128; b.O = Y + (size_t)(x * 256) * DM + 1024 + h * 128;
    b.CL = CL + (size_t)h * S; b.P0 = x * 256; b.jlo = jlo; b.Q2 = nullptr; b.GS = GSP + (size_t)(x * 256) * 24 + 16 + h; return b;
}
#define CAS __attribute__((address_space(4)))
struct Args { const float* in[30]; float* out; unsigned char* ws; int ph_lo, ph_hi; };

__global__ void __launch_bounds__(512, 2) fwd_kernel(Args a) {
    extern __shared__ __attribute__((aligned(16))) unsigned char lds[];
    LAS unsigned char* ldsl = (LAS unsigned char*)lds;
    cg::grid_group grid = cg::this_grid();
    const int G = gridDim.x;
    volatile LAS unsigned* stw = (volatile LAS unsigned*)(ldsl + LDS_BYTES - 64);
    if (threadIdx.x < 2) stw[threadIdx.x] = 0u;
    __syncthreads();
    const XcdBarrier xbar = xcd_barrier_post((unsigned*)(a.ws + WS_BAR), stw);
    for (int ph = a.ph_lo; ph < a.ph_hi; ++ph) {
        const int tid = opaque_tid(), lane = tid & 63, wid = __builtin_amdgcn_readfirstlane(tid >> 6);
        int bid = blockIdx.x; asm volatile("" : "+s"(bid));
        const CAS Args* ap = (const CAS Args*)__builtin_amdgcn_kernarg_segment_ptr(); asm volatile("" : "+s"(ap));
        unsigned char* ws = ap->ws; float* X = ap->out;
        const int gw = bid * 8 + wid, NGW = G * 8;
        float* FL = (float*)(ws + WS_FL); float* CL = (float*)(ws + WS_CL);
        bf16* MEMN = (bf16*)(ws + WS_MEMN); bf16* KVX = (bf16*)(ws + WS_KVX); bf16* XB = (bf16*)(ws + WS_XB); bf16* HID = (bf16*)(ws + WS_HID);
        bf16* Z = (bf16*)(ws + WS_Z); bf16* PC = (bf16*)(ws + WS_PC); bf16* Y = (bf16*)(ws + WS_Y); bf16* QX = (bf16*)(ws + WS_QX); bf16* OX = (bf16*)(ws + WS_OX); bf16* QX2 = (bf16*)(ws + WS_QX2); float* GSP = (float*)(ws + WS_GSP);
        bf16* WALL = (bf16*)(ws + WS_W);
        float* NRM = (float*)(ws + WS_CTL);
        float* RSA = (float*)(ws + WS_RSA); float* RSB = (float*)(ws + WS_RSB);
        LAS float* rsl = (LAS float*)(ldsl + 131072);
        if (ph == 0) { if constexpr (PH_EN(16)) {
            LAS float* scr = (LAS float*)(ldsl + wid * 16384);
            constexpr int I_F = (DM / 64) * (DFF / 32), I_MI = (DM / 64) * (NZ / 32), I_PW = 8 * 16, I_MO = 32 * 64, I_X = 32 * 16, I_XO = 8 * 64;
            constexpr int I_FG = DM / 64;
            constexpr int I_LAYER = 6 * I_F + I_MI + I_FG + I_PW + I_MO + 3 * I_X + I_XO;
            for (int it = gw; it < NLAYER * I_LAYER; it += NGW) {
                const int l = it / I_LAYER; int r = it % I_LAYER; bf16* WL = WALL + (size_t)l * LAYER_W;
                const size_t oF = (size_t)l * DM * DFF;
                if (r < I_F) { tr_job(r, ap->in[3] + oF, DFF, DM, DFF, WL + OW_GU1, 0, ap->in[2] + l * DM, 1, scr, lane); continue; } r -= I_F;
                if (r < I_F) { tr_job(r, ap->in[4] + oF, DFF, DM, DFF, WL + OW_GU1, 0, ap->in[2] + l * DM, 2, scr, lane); continue; } r -= I_F;
                if (r < I_F) { tr_job(r, ap->in[5] + oF, DM, DFF, DM, WL + OW_D1, 0, nullptr, 0, scr, lane); continue; } r -= I_F;
                if (r < I_F) { tr_job(r, ap->in[26] + oF, DFF, DM, DFF, WL + OW_GU2, 0, ap->in[25] + l * DM, 1, scr, lane); continue; } r -= I_F;
                if (r < I_F) { tr_job(r, ap->in[27] + oF, DFF, DM, DFF, WL + OW_GU2, 0, ap->in[25] + l * DM, 2, scr, lane); continue; } r -= I_F;
                if (r < I_F) { tr_job(r, ap->in[28] + oF, DM, DFF, DM, WL + OW_D2, 0, nullptr, 0, scr, lane); continue; } r -= I_F;
                if (r < I_MI) { tr_job(r, ap->in[7] + (size_t)l * DM * PIN, PIN, DM, NZ, WL + OW_MI, 0, ap->in[6] + l * DM, 3, scr, lane); continue; } r -= I_MI;
                if (r < I_FG) { tr_item(ap->in[7] + (size_t)l * DM * PIN, PIN, 3072, 64 * r, WL + OW_MI, DM, NZ, ap->in[6] + l * DM, scr, lane); continue; } r -= I_FG;
                if (r < I_PW) { tr_job(r, ap->in[14] + (size_t)l * 512 * 512, 512, 512, 512, WL + OW_PP, 512, nullptr, 0, scr, lane); continue; } r -= I_PW;
                if (r < I_MO) { tr_job(r, ap->in[18] + (size_t)l * DM * DM, DM, DM, DM, WL + OW_MO, 0, ap->in[17] + l * DM, 0, scr, lane); continue; } r -= I_MO;
                if (r < I_X) { tr_job(r, ap->in[21] + (size_t)l * DM * 512, 512, DM, 512, WL + OW_XQ, 0, ap->in[19] + l * DM, 0, scr, lane); continue; } r -= I_X;
                if (r < I_X) { tr_job(r, ap->in[22] + (size_t)l * DM * 512, 512, DM, 512, WL + OW_XKV, 0, ap->in[20] + l * DM, 0, scr, lane); continue; } r -= I_X;
                if (r < I_X) { tr_job(r, ap->in[23] + (size_t)l * DM * 512, 512, DM, 512, WL + OW_XKV, 512, ap->in[20] + l * DM, 0, scr, lane); continue; } r -= I_X;
                tr_job(r, ap->in[24] + (size_t)l * 512 * DM, DM, 512, DM, WL + OW_XO, 0, nullptr, 0, scr, lane);
            }
            for (int idx = bid * 512 + tid; idx < NLAYER * 512 * 512; idx += G * 512) { const int l = idx >> 18, n = (idx >> 9) & 511, k = idx & 511;
                float v = 0.f; if ((n >> 7) == (k >> 7)) v = ap->in[8][(size_t)l * 65536 + (size_t)(n >> 7) * 16384 + (k & 127) * 128 + (n & 127)] * ap->in[9][l * 512 + n];
                (WALL + (size_t)l * LAYER_W + OW_PP)[n * 512 + k] = (bf16)f2bf(v); }
            norm_rows<0>(ap->in[1], MEMN, nullptr, nullptr, nullptr, nullptr, NMEM, gw, NGW, lane);
            split_rows(ap->in[0], XB, RSB, gw, NGW, lane);
        } } else {
            const int l = (ph - 1) >> 4, sub = (ph - 1) & 15;
            if (sub == 2 || sub == 6 || sub == 8 || sub == 12 || (sub == 15 && l + 1 < NLAYER)) continue;
            bf16* WL = WALL + (size_t)l * LAYER_W;
            switch (sub) {
            case 0: case 13: if constexpr (PH_EN(0)) {
                pg8::Gemm g{XB, WL + (sub == 0 ? OW_GU1 : OW_GU2), S, 2 * DFF, DM}; pg8::StaticOrder So; So.init(S, 2 * DFF, G, bid);
                pg8::EpiSwiGLU E{HID, DFF, sub == 0 ? RSB : RSA, rsl};
                pg8::gemm_phase<pg8::EpiSwiGLU, pg8::StaticOrder, true, true>(ldsl, g, So, E);
            } break;
            case 1: case 14: if constexpr (PH_EN(1)) {
                pg8::Gemm g{HID, WL + (sub == 1 ? OW_D1 : OW_D2), S, DM, DFF}; pg8::StaticOrder So; So.init(S, DM, G, bid);
                pg8::EpiResid<false> E{XB, sub == 1 ? RSA : RSB, 0.5f, 0}; pg8::gemm_phase<pg8::EpiResid<false>, pg8::StaticOrder, true, true>(ldsl, g, So, E);
            } break;
            case 2: break;
            case 3: if constexpr (PH_EN(3)) {
                pg8::Gemm g{XB, WL + OW_MI, S, NZP, DM}; pg8::StaticOrder So; So.init(S, NZP, G, bid);
                pg8::EpiBf<0> E{Z, NZ, RSA, rsl, -1, FL, NZ / 256, nullptr, 1};
                pg8::gemm_phase<pg8::EpiBf<0>, pg8::StaticOrder, true, true>(ldsl, g, So, E);
                if (bid >= 192 && bid < 196) {
                    __syncthreads();
                    pg8::Gemm g2{MEMN, WL + OW_XKV, NMEM, 1024, DM, 0}; pg8::StaticOrder S2; S2.init(NMEM, 1024, 64, bid - 192);
                    pg8::EpiBf<0> E2{KVX, 1024, nullptr, rsl, -1, nullptr, 0};
                    pg8::gemm_phase<pg8::EpiBf<0>, pg8::StaticOrder, true, true>(ldsl, g2, S2, E2);
                }
            } break;
            case 4: if constexpr (PH_EN(4)) {
                if (bid < 4) scan_head(FL, ap->in[15][l * 4 + bid], CL + (size_t)bid * S, bid, ldsl, tid);
                for (int c0 = 2 * bid; c0 < S / 32; c0 += 2 * G)
                for (int c = c0; c < c0 + 2; ++c) {
                    const int t2 = opaque_tid();
                    ew_chunk(Z, PC, Y, ap->in[10] + l * 31 * 512, ap->in[11] + l * 512, ap->in[12] + l * 512, ap->in[13] + l * 512, ap->in[16] + l * 3 * 512, NRM, (LAS float*)ldsl, c, t2, __builtin_amdgcn_readfirstlane(t2 >> 6), t2 & 63);
                }
            } break;
            case 5: if constexpr (PH_EN(5)) {
                { pg8::Gemm g{PC, WL + OW_PP, 2 * S, 1024, 512}; pg8::PPOrder So{G, bid}; pg8::EpiBf<1> E{Y, DM, nullptr, rsl, -1, nullptr, 0, GSP};
                  pg8::gemm_phase<pg8::EpiBf<1>, pg8::PPOrder, true, true>(ldsl, g, So, E); }
                __syncthreads();
                for (int item = bid; item < 256; item += G) {
                    const int h = item & 3, qb = item >> 2;
                    float km, qm = 0.f;
                    { const f32x4 kv = *(const f32x4*)(NRM + (size_t)(4 + h) * 2048 + 4 * tid); km = fmaxf(fmaxf(kv[0], kv[1]), fmaxf(kv[2], kv[3]));
                      if (tid < 8) { const f32x4 qv = *(const f32x4*)(NRM + (size_t)h * 2048 + 32 * qb + 4 * tid); qm = fmaxf(fmaxf(qv[0], qv[1]), fmaxf(qv[2], qv[3])); }
#pragma unroll
                      for (int o = 1; o < 64; o <<= 1) { km = fmaxf(km, __shfl_xor(km, o)); qm = fmaxf(qm, __shfl_xor(qm, o)); }
                      LAS float* red = (LAS float*)(ldsl + 139264);
                      if (lane == 0) { red[wid] = km; red[8 + wid] = qm; }
                      __syncthreads();
#pragma unroll
                      for (int w8 = 0; w8 < 8; ++w8) { km = fmaxf(km, red[w8]); qm = fmaxf(qm, red[8 + w8]); } }
                    const float qk = 2.0f * att::C2 * 1.001f * sqrtf(qm * km);
                    const float* CLh = CL + (size_t)h * S;
                    const bool skip = (tid < qb * 4) && (CLh[qb * 256] - CLh[64 * tid + 63] + qk < -48.0f);
                    int jlo;
                    { LAS int* cnt8 = (LAS int*)(ldsl + 139264 + 128);
                      const int wc_ = __popcll(__ballot(skip)); if (lane == 0) cnt8[wid] = wc_;
                      __syncthreads();
                      int tot = 0;
#pragma unroll
                      for (int w8 = 0; w8 < 8; ++w8) tot += cnt8[w8];
                      jlo = __builtin_amdgcn_readfirstlane(tot); }
                    att::Seam Sm;
                    const att::BlockRef cur = fox_block(Z, Y, CL, GSP, h, qb, jlo);
                    att::attn_prime<NZ, NZ>(cur, (char*)lds, Sm);
                    att::attn_block<true, NZ, NZ, DM>(cur, cur, S, 0x40000000u, (char*)lds, (LAS float*)(ldsl + att::CLDS_OFF), Sm);
                    asm volatile("s_waitcnt vmcnt(0)" ::: "memory"); __syncthreads();
                }
            } break;
            case 6: if constexpr (PH_EN(6)) group_norm_rows(Y, gw, NGW, lane); break;
            case 7: if constexpr (PH_EN(7)) {
                pg8::Gemm g{Y, WL + OW_MO, S, DM, DM}; pg8::StaticOrder So; So.init(S, DM, G, bid);
                pg8::EpiResid<true> E{XB, RSB, 1.0f, 0, GSP, (LAS float*)(ldsl + 131072 + 1024), -1};
                pg8::gemm_phase<pg8::EpiResid<true>, pg8::StaticOrder, true, true>(ldsl, g, So, E);
            } break;
            case 8: case 12: if constexpr (PH_EN(8)) norm_rows<0>(X, XB, nullptr, nullptr, nullptr, nullptr, S, gw, NGW, lane); break;
            case 9: if constexpr (PH_EN(9)) {
                const int kh = bid >> 7;
                pg8::Gemm g{XB + kh * 1024, WL + OW_XQ + kh * 1024, S, 512, 1024, DM}; pg8::StaticOrder So; So.init(S, 512, 128, bid & 127);
                pg8::EpiBf<0> E{kh ? QX2 : QX, 512, RSB, rsl, -1, nullptr, 0};
                pg8::gemm_phase<pg8::EpiBf<0>, pg8::StaticOrder, true, true>(ldsl, g, So, E);
            } break;
            case 10: if constexpr (PH_EN(10)) {
                for (int item = bid; item < 256; item += G) {
                    const int h = item & 3, qb = item >> 2;
                    att::BlockRef b0;
                    b0.Q = QX + (size_t)(qb * 256) * 512 + h * 128; b0.K = KVX + h * 128; b0.V = KVX + 512 + h * 128; b0.O = OX + (size_t)(qb * 256) * 512 + h * 128;
                    b0.CL = nullptr; b0.P0 = 256; b0.jlo = 0; b0.Q2 = QX2 + (size_t)(qb * 256) * 512 + h * 128; b0.GS = nullptr;
                    att::Seam Sm;
                    att::attn_prime<512, 1024, true>(b0, (char*)lds, Sm);
                    att::attn_block<false, 512, 1024, 512>(b0, b0, NMEM, 0x40000000u, (char*)lds, (LAS float*)(ldsl + att::CLDS_OFF), Sm);
                    asm volatile("s_waitcnt vmcnt(0)" ::: "memory"); __syncthreads();
                }
            } break;
            case 11: if constexpr (PH_EN(11)) {
                pg8::Gemm g{OX, WL + OW_XO, S, DM, 512}; pg8::StaticOrder So; So.init(S, DM, G, bid);
                pg8::EpiResid<false> E{XB, RSA, 1.0f, 0};
                pg8::gemm_phase<pg8::EpiResid<false>, pg8::StaticOrder, true, true>(ldsl, g, So, E);
            } break;
            case 15: if constexpr (PH_EN(15)) {
                if (l + 1 < NLAYER) norm_rows<0>(X, XB, nullptr, nullptr, nullptr, nullptr, S, gw, NGW, lane);
                else final_rows(XB, RSB, ap->in[29], X, gw, NGW, lane); }
                break;
            }
        }
        if (ph + 1 < a.ph_hi) { if (ph == 0) grid.sync(); else xcd_barrier(xbar); }
    }
}

extern "C" void kernel_launch(void* const* d_in, const int* in_sizes, int n_in, void* d_out, int out_size, void* d_ws, size_t ws_size, hipStream_t stream) {
    static int grid = 0;
    if (grid == 0) {
        if (n_in != 30 || in_sizes[0] != S * DM || out_size != S * DM || ws_size < WS_NEED) { fprintf(stderr, "kernel_launch: unexpected shapes (n_in %d, in0 %d, out %d, ws %zu)\n", n_in, n_in > 0 ? in_sizes[0] : -1, out_size, ws_size); grid = -1; return; }
        int dev = 0, cus = 0, per_cu = 0;
        if (hipGetDevice(&dev) != hipSuccess || hipDeviceGetAttribute(&cus, hipDeviceAttributeMultiprocessorCount, dev) != hipSuccess) { grid = -1; return; }
        if (hipFuncSetAttribute((const void*)fwd_kernel, hipFuncAttributeMaxDynamicSharedMemorySize, LDS_BYTES) != hipSuccess) { fprintf(stderr, "kernel_launch: hipFuncSetAttribute failed\n"); grid = -1; return; }
        if (hipOccupancyMaxActiveBlocksPerMultiprocessor(&per_cu, (const void*)fwd_kernel, 512, LDS_BYTES) != hipSuccess || per_cu < 1) { fprintf(stderr, "kernel_launch: occupancy query says %d\n", per_cu); per_cu = 1; }
        (void)hipGetLastError();
        grid = cus;
        if (grid != 256) { fprintf(stderr, "kernel_launch: built for a 256-CU device, found %d CUs\n", cus); grid = -1; return; }
    }
    if (grid < 0) return;
    if (hipMemsetAsync((char*)d_ws + WS_BAR, 0, XCD_BAR_WORDS * 4, stream) != hipSuccess) { fprintf(stderr, "kernel_launch: memset of the barrier words failed\n"); return; }
    Args a{};
    for (int i = 0; i < 30; ++i) a.in[i] = (const float*)d_in[i];
    a.out = (float*)d_out; a.ws = (unsigned char*)d_ws;
#if MK_PER_PHASE
    for (int ph = 0; ph < NPH; ++ph) { a.ph_lo = ph; a.ph_hi = ph + 1; hipLaunchKernelGGL(fwd_kernel, dim3(grid), dim3(512), LDS_BYTES, stream, a); }
#else
    a.ph_lo = 0; a.ph_hi = NPH;
    void* args[] = {&a};
    hipError_t e = hipLaunchCooperativeKernel((const void*)fwd_kernel, dim3(grid), dim3(512), args, LDS_BYTES, stream);
    if (e != hipSuccess) fprintf(stderr, "kernel_launch: cooperative launch failed: %s\n", hipGetErrorString(e));
#endif
}
```

```cpp
#define MK_PER_PHASE 0
#include <hip/hip_runtime.h>
#include <hip/hip_cooperative_groups.h>
#include <cstdio>
#include <cstdint>
namespace cg = cooperative_groups;
#define LAS __attribute__((address_space(3)))
typedef short bf16x8 __attribute__((ext_vector_type(8)));
typedef short s16x4 __attribute__((ext_vector_type(4)));
typedef float f32x4 __attribute__((ext_vector_type(4)));
typedef float f32x16 __attribute__((ext_vector_type(16)));
typedef unsigned u32x4 __attribute__((ext_vector_type(4)));
__device__ __forceinline__ int opaque_tid() { int t = threadIdx.x; asm volatile("" : "+v"(t)); return t; }
namespace pg8 {
#define PG8_LAS __attribute__((address_space(3)))
typedef unsigned short bf16_t;
typedef short bf16x8 __attribute__((ext_vector_type(8)));
typedef float f32x4 __attribute__((ext_vector_type(4)));
typedef unsigned u32x4 __attribute__((ext_vector_type(4)));
constexpr int BM = 256, BK = 64, HALF = 128, HTB = HALF * BK * 2  , STAGE_BYTES = 8 * HTB, NXCD = 8, WGM = 8;

__host__ __device__ __forceinline__ int lds_byte(int r, int c) { const int st = (r >> 4) * 2 + (c >> 5), rr = r & 15, cc = c & 31, ob = rr * 64 + cc * 2; return st * 1024 + (ob ^ (((ob >> 9) & 1) << 5)); }
__host__ __device__ __forceinline__ void stage_rc(int b, int& R, int& C) { const int st = b / 1024, sb = b % 1024, swz = sb ^ (((sb >> 9) & 1) << 5); R = (st >> 1) * 16 + swz / 64; C = (st & 1) * 32 + (swz % 64) / 2; }
__host__ __device__ __forceinline__ int perm32(int rho) { const int n = rho >> 4, i = rho & 15; return 8 * (i >> 2) + 4 * n + (i & 3); }

struct Unit { int pm, pn; };
struct Gemm { const bf16_t* A; const bf16_t* Bt; int M, N, K; int ld; };

struct StaticOrder {
    int nM, nN, nwg, G, c;
    __host__ __device__ void init(int M, int N, int G_, int c_) { nM = M / BM; nN = N / BM; nwg = nM * nN; G = G_; c = c_; }
    __host__ __device__ bool next(int i, Unit& u) const {
        const long L = (long)i * G + c; if (L >= nwg) return false;
        int wgid = (int)L; { const int q = nwg / NXCD, r = nwg % NXCD, xcd = wgid % NXCD, off = wgid / NXCD; wgid = (xcd < r ? xcd * (q + 1) : r * (q + 1) + (xcd - r) * q) + off; }
        const int nig = WGM * nN, gid = wgid / nig, fm = gid * WGM, gsz = (nM - fm) < WGM ? (nM - fm) : WGM;
        u.pm = fm + ((wgid % nig) % gsz); u.pn = (wgid % nig) / gsz; return true;
    }
    __device__ __forceinline__ void a_ready(const Unit&) const {}
    __device__ __forceinline__ void done(const Unit&) const {}
};

__device__ __forceinline__ unsigned cvt_pk_bf16(float lo, float hi) { unsigned r; asm volatile("v_cvt_pk_bf16_f32 %0, %1, %2" : "=v"(r) : "v"(lo), "v"(hi)); return r; }

__device__ __forceinline__ float silu_f(float g) { return g * __builtin_amdgcn_rcpf(1.0f + __builtin_amdgcn_exp2f(-1.4426950408889634f * g)); }

__device__ __forceinline__ void rstd_to_lds(const float* RSP, PG8_LAS float* rsl, int pm) {
    const int t = opaque_tid(), row = t >> 1, half = t & 1;
    const f32x4* p = (const f32x4*)(RSP + ((size_t)(pm * BM + row)) * 32 + half * 16);
    const f32x4 a = p[0], b = p[1], c = p[2], d = p[3];
    float s = ((a[0] + a[1]) + (a[2] + a[3])) + ((b[0] + b[1]) + (b[2] + b[3])) + ((c[0] + c[1]) + (c[2] + c[3])) + ((d[0] + d[1]) + (d[2] + d[3]));
    s += __shfl_xor(s, 1);
    if (half == 0) rsl[row] = 1.0f / sqrtf(s * (1.0f / 2048.0f) + 1e-6f);
    asm volatile("s_waitcnt lgkmcnt(0)" ::: "memory"); __builtin_amdgcn_s_barrier(); asm volatile("" ::: "memory");
}
struct EpiSwiGLU {
    static constexpr bool PERM = true, AFTER_DRAIN = false, KSEG = false;
    bf16_t* O; int ldc; const float* RSP; PG8_LAS float* rsl;
    mutable int last_pm = -1;
    __device__ __forceinline__ void operator()(const f32x4 (&acc)[2][2][4][2], const Unit& u, int wr, int wc, int fr, int fq) const {
        if (u.pm != last_pm) { rstd_to_lds(RSP, rsl, u.pm); last_pm = u.pm; }
        const int row0 = u.pm * BM + wr * 64 + fr, col0 = u.pn * HALF + wc * 32 + 8 * fq;
#pragma unroll
        for (int ai = 0; ai < 2; ++ai)
#pragma unroll
            for (int m = 0; m < 4; ++m) { const int row = row0 + ai * HALF + m * 16; bf16_t* rowp = O + (size_t)row * ldc + col0;
                const float rs = rsl[wr * 64 + fr + ai * HALF + m * 16];
                const f32x4 g0 = acc[ai][0][m][0] * rs, g1 = acc[ai][0][m][1] * rs, u0 = acc[ai][1][m][0] * rs, u1 = acc[ai][1][m][1] * rs;
                u32x4 w;
                w.x = cvt_pk_bf16(silu_f(g0[0]) * u0[0], silu_f(g0[1]) * u0[1]); w.y = cvt_pk_bf16(silu_f(g0[2]) * u0[2], silu_f(g0[3]) * u0[3]);
                w.z = cvt_pk_bf16(silu_f(g1[0]) * u1[0], silu_f(g1[1]) * u1[1]); w.w = cvt_pk_bf16(silu_f(g1[2]) * u1[2], silu_f(g1[3]) * u1[3]);
                *(u32x4*)rowp = w; }
    }
};
template <bool FLG> struct EpiResid {
    static constexpr bool PERM = true, AFTER_DRAIN = false, KSEG = FLG;
    bf16_t* XH; float* RSP; float alpha; int pad_;
    const float* GSP = nullptr; PG8_LAS float* gtab = nullptr; mutable int last_pm = -1;
    __device__ __forceinline__ void prep(const Unit& u) const {
        if (u.pm == last_pm) return;
        last_pm = u.pm;
        const int t = opaque_tid();
        if (t < 256) { const f32x4* p = (const f32x4*)(GSP + (size_t)(u.pm * BM + t) * 24);
            const f32x4 a0 = p[0], a1 = p[1], b0 = p[2], b1 = p[3], c0 = p[4];
            const float sa = ((a0[0] + a0[1]) + (a0[2] + a0[3])) + ((a1[0] + a1[1]) + (a1[2] + a1[3])), sb = ((b0[0] + b0[1]) + (b0[2] + b0[3])) + ((b1[0] + b1[1]) + (b1[2] + b1[3])), sc = (c0[0] + c0[1]) + (c0[2] + c0[3]);
            const float r0 = 1.0f / sqrtf(sa * (1.0f / 512.0f) + 1e-6f), r1 = 1.0f / sqrtf(sb * (1.0f / 512.0f) + 1e-6f), r2 = 1.0f / sqrtf(sc * (1.0f / 512.0f) + 1e-6f);
            gtab[t] = r0 / r1; gtab[256 + t] = r1 / r2; gtab[512 + t] = r2; }
        asm volatile("s_waitcnt lgkmcnt(0)" ::: "memory"); __builtin_amdgcn_s_barrier(); asm volatile("" ::: "memory");
    }
    __device__ __forceinline__ void rescale(f32x4 (&acc)[2][2][4][2], int seg, int wr, int fr) const {
#pragma unroll
        for (int ai = 0; ai < 2; ++ai)
#pragma unroll
            for (int m = 0; m < 4; ++m) { const float rho = gtab[(seg - 1) * 256 + wr * 64 + fr + ai * HALF + m * 16];
#pragma unroll
                for (int bj = 0; bj < 2; ++bj)
#pragma unroll
                    for (int n = 0; n < 2; ++n) acc[ai][bj][m][n] = acc[ai][bj][m][n] * rho; }
    }
    __device__ __forceinline__ void operator()(const f32x4 (&acc)[2][2][4][2], const Unit& u, int wr, int wc, int fr, int fq) const {
        const int row0 = u.pm * BM + wr * 64 + fr, col0 = u.pn * BM + wc * 32 + 8 * fq;
#pragma unroll
        for (int ai = 0; ai < 2; ++ai)
#pragma unroll
            for (int mh = 0; mh < 2; ++mh) {
                u32x4 h[2][2];
#pragma unroll
                for (int m2 = 0; m2 < 2; ++m2)
#pragma unroll
                    for (int bj = 0; bj < 2; ++bj) { const size_t off = (size_t)(row0 + ai * HALF + (mh * 2 + m2) * 16) * 2048 + col0 + bj * HALF;
                        h[m2][bj] = *(const u32x4*)(XH + off); }
                __builtin_amdgcn_sched_barrier(0);
#pragma unroll
                for (int m2 = 0; m2 < 2; ++m2) { const int m = mh * 2 + m2, row = row0 + ai * HALF + m * 16;
                    float ss = 0.f;
#pragma unroll
                    for (int bj = 0; bj < 2; ++bj) { const size_t off = (size_t)row * 2048 + col0 + bj * HALF; u32x4 nh;
#pragma unroll
                        for (int w = 0; w < 4; ++w) { const unsigned hw = h[m2][bj][w];
                            const float a0 = acc[ai][bj][m][w >> 1][(w & 1) * 2], a1 = acc[ai][bj][m][w >> 1][(w & 1) * 2 + 1];
                            const float v0 = __uint_as_float(hw << 16) + a0 * alpha, v1 = __uint_as_float(hw & 0xffff0000u) + a1 * alpha;
                            const unsigned ph = cvt_pk_bf16(v0, v1);
                            nh[w] = ph;
                            ss += v0 * v0 + v1 * v1; }
                        *(u32x4*)(XH + off) = nh; }
                    ss += __shfl_xor(ss, 16); ss += __shfl_xor(ss, 32);
                    if (fq == 0) RSP[(size_t)row * 32 + u.pn * 4 + wc] = ss; }
                __builtin_amdgcn_sched_barrier(0);
            }
    }
};
template <int MODE> struct EpiBf {
    static constexpr bool PERM = true, AFTER_DRAIN = false, KSEG = false;
    bf16_t* O; int ldc; const float* RSP; PG8_LAS float* rsl;
    mutable int last_pm = -1;
    float* FLp; int fl_tile; float* GSP = nullptr; int mixmode = 0;
    __device__ __forceinline__ void operator()(const f32x4 (&acc)[2][2][4][2], const Unit& u, int wr, int wc, int fr, int fq) const {
        if (MODE == 0 && RSP && u.pm != last_pm) { rstd_to_lds(RSP, rsl, u.pm); last_pm = u.pm; }
        if (MODE == 0 && FLp && u.pn == fl_tile) {
            if (wc == 0 && fq == 0) {
#pragma unroll
                for (int ai = 0; ai < 2; ++ai)
#pragma unroll
                    for (int m = 0; m < 4; ++m) { const int row = u.pm * BM + wr * 64 + fr + ai * HALF + m * 16;
                        const float rs = rsl[wr * 64 + fr + ai * HALF + m * 16];
                        *(f32x4*)(FLp + (size_t)row * 4) = acc[ai][0][m][0] * rs; } }
            return; }
        if (MODE == 0 && mixmode && ((u.pn >= 2 && u.pn < 6) || (u.pn >= 14 && u.pn < 18))) {
            const bool glu = u.pn < 6; const int ocol = (glu ? 512 + 128 * (u.pn - 2) : 3584 + 128 * (u.pn - 14)) + wc * 32 + 8 * fq;
#pragma unroll
            for (int ai = 0; ai < 2; ++ai)
#pragma unroll
                for (int m = 0; m < 4; ++m) { const int row = u.pm * BM + wr * 64 + fr + ai * HALF + m * 16; const float rs = rsl[wr * 64 + fr + ai * HALF + m * 16];
                    const f32x4 a0 = acc[ai][0][m][0] * rs, a1 = acc[ai][0][m][1] * rs; f32x4 g0 = acc[ai][1][m][0] * rs, g1 = acc[ai][1][m][1] * rs;
                    if (glu) {
#pragma unroll
                        for (int e = 0; e < 4; ++e) { g0[e] = __builtin_amdgcn_rcpf(1.0f + __builtin_amdgcn_exp2f(-1.4426950408889634f * g0[e])); g1[e] = __builtin_amdgcn_rcpf(1.0f + __builtin_amdgcn_exp2f(-1.4426950408889634f * g1[e])); } }
                    const f32x4 v0 = a0 * g0, v1 = a1 * g1;
                    u32x4 w; w.x = cvt_pk_bf16(v0[0], v0[1]); w.y = cvt_pk_bf16(v0[2], v0[3]); w.z = cvt_pk_bf16(v1[0], v1[1]); w.w = cvt_pk_bf16(v1[2], v1[3]);
                    *(u32x4*)(O + (size_t)row * ldc + ocol) = w; }
            return; }
        int prow = u.pm, pcol = u.pn * BM;
        if (MODE == 1) { prow = u.pm & 63; pcol = (u.pm >> 6) * 512 + (u.pn & 1) * 256; }
        const int row0 = prow * BM + wr * 64 + fr, col0 = pcol + wc * 32 + 8 * fq;
#pragma unroll
        for (int ai = 0; ai < 2; ++ai)
#pragma unroll
            for (int m = 0; m < 4; ++m) { const int row = row0 + ai * HALF + m * 16; bf16_t* rowp = O + (size_t)row * ldc + col0;
                const float rs = (MODE == 0 && RSP) ? rsl[wr * 64 + fr + ai * HALF + m * 16] : 1.0f;
                float ss = 0.f;
#pragma unroll
                for (int bj = 0; bj < 2; ++bj) { const f32x4 v0 = acc[ai][bj][m][0] * rs, v1 = acc[ai][bj][m][1] * rs;
                    u32x4 w; w.x = cvt_pk_bf16(v0[0], v0[1]); w.y = cvt_pk_bf16(v0[2], v0[3]); w.z = cvt_pk_bf16(v1[0], v1[1]); w.w = cvt_pk_bf16(v1[2], v1[3]);
                    if (MODE == 1) ss += ((v0[0] * v0[0] + v0[1] * v0[1]) + (v0[2] * v0[2] + v0[3] * v0[3])) + ((v1[0] * v1[0] + v1[1] * v1[1]) + (v1[2] * v1[2] + v1[3] * v1[3]));
                    *(u32x4*)(rowp + bj * HALF) = w; }
                if (MODE == 1) { ss += __shfl_xor(ss, 16); ss += __shfl_xor(ss, 32);
                    if (fq == 0) GSP[(size_t)row * 24 + (u.pm >> 6) * 8 + (u.pn & 1) * 4 + wc] = ss; } }
    }
};
struct PPOrder {
    int G, c;
    __device__ __forceinline__ bool next(int i, Unit& u) const { const int L = i * G + c; if (L >= 256) return false; u.pm = L >> 1; u.pn = (L & 1) + ((L >> 7) << 1); return true; }
    __device__ __forceinline__ void a_ready(const Unit&) const {}
    __device__ __forceinline__ void done(const Unit&) const {}
};
template <class Epi, class Sched, bool ALIGN_EPI = false, bool SP2 = false>
__device__ __forceinline__ void gemm_phase(PG8_LAS unsigned char* lds, const Gemm g, const Sched& S, const Epi& E) {
    const int tid = opaque_tid(), wid = __builtin_amdgcn_readfirstlane(tid >> 6), lane = tid & 63, wr = wid >> 2, wc = wid & 3, fr = lane & 15, fq = lane >> 4;
    const int K = g.K, nt = K / BK, LD = g.ld ? g.ld : K;
    unsigned voffA[2], voffB[2];
#pragma unroll
    for (int i = 0; i < 2; ++i) { int R, C; stage_rc(tid * 16 + i * 8192, R, C); const int Rb = Epi::PERM ? ((R & ~31) + perm32(R & 31)) : R;
        voffA[i] = (unsigned)(R * LD + C) * 2u; voffB[i] = (unsigned)(Rb * LD + C) * 2u; }
    const size_t kstep = (size_t)(BK * 2);
    const size_t hstep = (size_t)HALF * LD * 2;
    const size_t tstep = 2 * hstep;
    const unsigned ldsw = (unsigned)wid * 1024u;
    const int aoff = lds_byte(wr * 64 + fr, fq * 8), boff = lds_byte(wc * 32 + fr, fq * 8);
#define PG8_SA(b, h) (((b) * 2 + (h)) * HTB)
#define PG8_SB(b, h) ((4 + (b) * 2 + (h)) * HTB)
#define PG8_STAGE(bufoff, gbase, voff) do { _Pragma("unroll") for (int _i = 0; _i < 2; ++_i) \
        __builtin_amdgcn_global_load_lds((const unsigned*)((const char*)(gbase) + (voff)[_i]), (PG8_LAS unsigned*)(lds + (bufoff) + ldsw + _i * 8192), 16, 0, 0); } while (0)
#define PG8_LDA(dst, b, h) do { _Pragma("unroll") for (int m = 0; m < 4; ++m) _Pragma("unroll") for (int k = 0; k < 2; ++k) dst[m][k] = *(const PG8_LAS bf16x8*)(lds + PG8_SA(b, h) + aoff + m * 2048 + k * 1024); } while (0)
#define PG8_LDB(dst, b, h) do { _Pragma("unroll") for (int n = 0; n < 2; ++n) _Pragma("unroll") for (int k = 0; k < 2; ++k) dst[n][k] = *(const PG8_LAS bf16x8*)(lds + PG8_SB(b, h) + boff + n * 2048 + k * 1024); } while (0)
#define PG8_MMA(ai, bj, At, Bt) do { __builtin_amdgcn_s_setprio(1); _Pragma("unroll") for (int m = 0; m < 4; ++m) _Pragma("unroll") for (int n = 0; n < 2; ++n) _Pragma("unroll") for (int k = 0; k < 2; ++k) \
        acc[ai][bj][m][n] = __builtin_amdgcn_mfma_f32_16x16x32_bf16(Bt[n][k], At[m][k], acc[ai][bj][m][n], 0, 0, 0); __builtin_amdgcn_s_setprio(0); } while (0)
#define PG8_WAIT_V(n) asm volatile("s_waitcnt vmcnt(" #n ")" ::: "memory")
#define PG8_WAIT_L(n) asm volatile("s_waitcnt lgkmcnt(" #n ")" ::: "memory")
#define PG8_BAR __builtin_amdgcn_s_barrier()
#define PG8_SCHED __builtin_amdgcn_sched_barrier(0)
    Unit cur, nxt; int ui = 0;
    if (!S.next(0, cur)) return;
    f32x4 acc[2][2][4][2];
#pragma unroll
    for (int a = 0; a < 2; ++a)
#pragma unroll
        for (int b = 0; b < 2; ++b)
#pragma unroll
            for (int m = 0; m < 4; ++m)
#pragma unroll
                for (int n = 0; n < 2; ++n) acc[a][b][m][n] = (f32x4){0.f, 0.f, 0.f, 0.f};
    bf16x8 At[4][2], B0[2][2], B1[2][2];
    const char* cA = (const char*)g.A + (size_t)cur.pm * tstep; const char* cB = (const char*)g.Bt + (size_t)cur.pn * tstep;
    if constexpr (Epi::KSEG) E.prep(cur);
    S.a_ready(cur);
    if constexpr (SP2) {
        PG8_STAGE(PG8_SB(0, 0), cB, voffB); PG8_STAGE(PG8_SB(0, 1), cB + hstep, voffB); PG8_STAGE(PG8_SA(0, 0), cA, voffA); PG8_STAGE(PG8_SA(0, 1), cA + hstep, voffA);
        if (wr == 1) PG8_BAR;
        PG8_WAIT_V(2); PG8_BAR;
        PG8_STAGE(PG8_SB(1, 0), cB + kstep, voffB); PG8_STAGE(PG8_SA(1, 0), cA + kstep, voffA); PG8_STAGE(PG8_SB(1, 1), cB + hstep + kstep, voffB);
        PG8_WAIT_V(6); PG8_BAR;
    } else {
        PG8_STAGE(PG8_SB(0, 0), cB, voffB); PG8_STAGE(PG8_SA(0, 0), cA, voffA); PG8_STAGE(PG8_SB(0, 1), cB + hstep, voffB); PG8_STAGE(PG8_SA(0, 1), cA + hstep, voffA);
        if (wr == 1) PG8_BAR;
        PG8_WAIT_V(4); PG8_BAR;
        PG8_STAGE(PG8_SB(1, 0), cB + kstep, voffB); PG8_STAGE(PG8_SA(1, 0), cA + kstep, voffA); PG8_STAGE(PG8_SB(1, 1), cB + hstep + kstep, voffB);
        PG8_WAIT_V(6); PG8_BAR;
    }
    for (;;) {
        const bool has_next = S.next(ui + 1, nxt);
        const char* nA = has_next ? (const char*)g.A + (size_t)nxt.pm * tstep : cA; const char* nB = has_next ? (const char*)g.Bt + (size_t)nxt.pn * tstep : cB;
        for (int t = 0; t < nt; t += 2) {
            if constexpr (Epi::KSEG) { if (t == 8 || t == 16 || t == 24) E.rescale(acc, t >> 3, wr, fr); }
            const bool last = (t == nt - 2);
            const char* a1 = cA + (size_t)(t + 1) * kstep;
            const char* a2 = last ? nA : cA + (size_t)(t + 2) * kstep; const char* b2 = last ? nB : cB + (size_t)(t + 2) * kstep;
            const char* a3 = a2 + kstep; const char* b3 = b2 + kstep;
            if (last && has_next) S.a_ready(nxt);
            if constexpr (SP2) {
            PG8_LDB(B0, 0, 0); PG8_LDB(B1, 0, 1); PG8_SCHED; PG8_LDA(At, 0, 0); PG8_STAGE(PG8_SA(1, 1), a1 + hstep, voffA);
            PG8_WAIT_V(8); PG8_WAIT_L(0); PG8_BAR; PG8_MMA(0, 0, At, B0); PG8_MMA(0, 1, At, B1); PG8_BAR; PG8_SCHED;
            PG8_LDA(At, 0, 1); PG8_STAGE(PG8_SB(0, 0), b2, voffB); PG8_STAGE(PG8_SB(0, 1), b2 + hstep, voffB); PG8_STAGE(PG8_SA(0, 0), a2, voffA);
            PG8_WAIT_V(8); PG8_WAIT_L(0); PG8_BAR; PG8_MMA(1, 0, At, B0); PG8_MMA(1, 1, At, B1); PG8_BAR; PG8_SCHED;
            PG8_LDB(B0, 1, 0); PG8_LDB(B1, 1, 1); PG8_SCHED; PG8_LDA(At, 1, 0); PG8_STAGE(PG8_SA(0, 1), a2 + hstep, voffA);
            PG8_WAIT_V(8); PG8_WAIT_L(0); PG8_BAR; PG8_MMA(0, 0, At, B0); PG8_MMA(0, 1, At, B1); PG8_BAR; PG8_SCHED;
            PG8_LDA(At, 1, 1); PG8_STAGE(PG8_SB(1, 0), b3, voffB); PG8_STAGE(PG8_SB(1, 1), b3 + hstep, voffB); PG8_STAGE(PG8_SA(1, 0), a3, voffA);
            PG8_WAIT_V(8); PG8_WAIT_L(0); PG8_BAR; PG8_MMA(1, 0, At, B0); PG8_MMA(1, 1, At, B1); PG8_BAR; PG8_SCHED;
            } else {
            PG8_LDB(B0, 0, 0); PG8_SCHED; PG8_LDA(At, 0, 0); PG8_STAGE(PG8_SA(1, 1), a1 + hstep, voffA);
            PG8_WAIT_L(8); PG8_BAR; PG8_WAIT_L(0); PG8_MMA(0, 0, At, B0); PG8_BAR; PG8_SCHED;
            PG8_LDB(B1, 0, 1); PG8_STAGE(PG8_SB(0, 0), b2, voffB);
            PG8_BAR; PG8_WAIT_L(0); PG8_MMA(0, 1, At, B1); PG8_BAR;
            PG8_LDA(At, 0, 1); PG8_STAGE(PG8_SA(0, 0), a2, voffA);
            PG8_BAR; PG8_WAIT_L(0); PG8_MMA(1, 0, At, B0); PG8_BAR; PG8_SCHED;
            PG8_STAGE(PG8_SB(0, 1), b2 + hstep, voffB);
            PG8_WAIT_V(6); PG8_BAR; PG8_MMA(1, 1, At, B1); PG8_BAR;
            PG8_LDB(B0, 1, 0); PG8_SCHED; PG8_LDA(At, 1, 0); PG8_STAGE(PG8_SA(0, 1), a2 + hstep, voffA);
            PG8_WAIT_L(8); PG8_BAR; PG8_WAIT_L(0); PG8_MMA(0, 0, At, B0); PG8_BAR; PG8_SCHED;
            PG8_LDB(B1, 1, 1); PG8_STAGE(PG8_SB(1, 0), b3, voffB);
            PG8_BAR; PG8_WAIT_L(0); PG8_MMA(0, 1, At, B1); PG8_BAR;
            PG8_LDA(At, 1, 1); PG8_STAGE(PG8_SA(1, 0), a3, voffA);
            PG8_BAR; PG8_WAIT_L(0); PG8_MMA(1, 0, At, B0); PG8_BAR; PG8_SCHED;
            PG8_STAGE(PG8_SB(1, 1), b3 + hstep, voffB);
            PG8_WAIT_V(6); PG8_BAR; PG8_MMA(1, 1, At, B1); PG8_BAR;
            }
        }
        if constexpr (ALIGN_EPI) { if (wr == 0) PG8_BAR; }
        if constexpr (!Epi::AFTER_DRAIN) { E(acc, cur, wr, wc, fr, fq); S.done(cur); }
        if (!has_next) break;
#pragma unroll
        for (int a = 0; a < 2; ++a)
#pragma unroll
            for (int b = 0; b < 2; ++b)
#pragma unroll
                for (int m = 0; m < 4; ++m)
#pragma unroll
                    for (int n = 0; n < 2; ++n) acc[a][b][m][n] = (f32x4){0.f, 0.f, 0.f, 0.f};
        cur = nxt; cA = nA; cB = nB; ++ui;
        if constexpr (Epi::KSEG) E.prep(cur);
        if constexpr (ALIGN_EPI) { if (wr == 1) PG8_BAR; }
    }
    PG8_WAIT_V(0);
    if constexpr (!ALIGN_EPI) { if (wr == 0) PG8_BAR; }
    PG8_BAR;
    if constexpr (Epi::AFTER_DRAIN) { E.fused(acc, cur, wr, wc, fr, fq, lds, wid, lane); S.done(cur); }
#undef PG8_SA
#undef PG8_SB
#undef PG8_STAGE
#undef PG8_LDA
#undef PG8_LDB
#undef PG8_MMA
#undef PG8_WAIT_V
#undef PG8_WAIT_L
#undef PG8_BAR
#undef PG8_SCHED
}
}
namespace att {
constexpr int D = 128, NW = 8, QBLK = 32, KVBLK = 64, QB = NW * QBLK;
constexpr int SHM_V = KVBLK * D * 2, SHM_K = KVBLK * D * 2;
constexpr int LDS_ATT = 2 * SHM_V + 2 * SHM_K + NW * 64 * 4;
constexpr int CLDS_OFF = LDS_ATT;
constexpr float SCALE = 0.08838834764831845f;
constexpr float C2 = 1.4426950408889634f * SCALE;
constexpr float THR2 = 8.f * 1.4426950408889634f;
typedef unsigned short bf16;

#define KSWZ(row, colB) ((row) * 256 + ((colB) ^ (((row) & 7) << 4)))
#define SBAR() __builtin_amdgcn_sched_barrier(0)
__device__ __forceinline__ int v_st(int k, int c) { const int kk = (k & ~0xC) | ((k & 4) << 1) | ((k & 8) >> 1); return ((kk >> 3) * 4 + (c >> 5)) * 512 + ((kk & 7) * 32 + (c & 31)) * 2; }
__device__ __forceinline__ int v_rd_base(int lane) { return ((lane & 3) << 3) | (((lane >> 2) & 3) << 6) | (((lane >> 4) & 1) << 5) | (((lane >> 5) & 1) << 8); }
constexpr int v_rd_off(int d0, int ks, int half) { return d0 * 512 + ks * 4096 + half * 2048; }
__device__ __forceinline__ int crow(int r, int hi) { return (r & 3) + 8 * (r >> 2) + 4 * hi; }
__device__ __forceinline__ unsigned cvtpk(float lo, float hi) { unsigned r; asm volatile("v_cvt_pk_bf16_f32 %0, %1, %2" : "=v"(r) : "v"(lo), "v"(hi)); return r; }
__device__ __forceinline__ bf16x8 load8(const bf16* p) { return *reinterpret_cast<const bf16x8*>(p); }
__device__ __forceinline__ void mask_tile(f32x16& p0, f32x16& p1, int dq, unsigned W) {
    const float NEG = -__builtin_inff();
#pragma unroll
    for (int r = 0; r < 16; ++r) {
        const int c = (r & 3) + 8 * (r >> 2);
        if ((unsigned)(dq - c) >= W) p0[r] = NEG;
        if ((unsigned)(dq - c - 32) >= W) p1[r] = NEG;
    }
}
__device__ __forceinline__ void partialSM(f32x16& p0, f32x16& p1, float& m_reg, float& mn, float& alpha, float cq) {
    float pmax = p0[0]; for (int r = 1; r < 16; ++r) pmax = fmaxf(pmax, p0[r]); for (int r = 0; r < 16; ++r) pmax = fmaxf(pmax, p1[r]);
    { auto rr = __builtin_amdgcn_permlane32_swap(__float_as_uint(pmax), __float_as_uint(pmax), false, false);
      pmax = fmaxf(__uint_as_float(rr[0]), __uint_as_float(rr[1])); }
    const float tmax = fmaf(pmax, C2, cq);
    if (__builtin_expect(__all((tmax - m_reg) <= THR2), 1)) { mn = m_reg; alpha = 1.f; }
    else { mn = fmaxf(m_reg, tmax); alpha = __builtin_amdgcn_exp2f(m_reg - mn); m_reg = mn; }
    const float mnL = cq - mn;
    for (int r = 0; r < 16; ++r) p0[r] = fmaf(p0[r], C2, mnL); for (int r = 0; r < 16; ++r) p1[r] = fmaf(p1[r], C2, mnL);
    for (int r = 0; r < 16; ++r) p0[r] = __builtin_amdgcn_exp2f(p0[r]);
}
__device__ __forceinline__ void finishSM(f32x16& p0, f32x16& p1, float alpha, float& l_reg, bf16x8& pa0, bf16x8& pa1, bf16x8& pa2, bf16x8& pa3) {
#pragma unroll
    for (int r = 0; r < 16; ++r) p1[r] = __builtin_amdgcn_exp2f(p1[r]);
    float ps = 0;
#pragma unroll
    for (int r = 0; r < 16; ++r) ps += p0[r];
#pragma unroll
    for (int r = 0; r < 16; ++r) ps += p1[r];
    { auto rr = __builtin_amdgcn_permlane32_swap(__float_as_uint(ps), __float_as_uint(ps), false, false);
      ps = __uint_as_float(rr[0]) + __uint_as_float(rr[1]); }
    l_reg = l_reg * alpha + ps;
#define PK4(P, B_, OUT) do { unsigned a0 = cvtpk(P[B_+0], P[B_+1]), a1 = cvtpk(P[B_+2], P[B_+3]);                          \
        unsigned b0 = cvtpk(P[B_+4], P[B_+5]), b1 = cvtpk(P[B_+6], P[B_+7]);                                             \
        auto r0 = __builtin_amdgcn_permlane32_swap(a0, b0, false, false); auto r1 = __builtin_amdgcn_permlane32_swap(a1, b1, false, false); \
        u32x4 w = {r0[0], r1[0], r0[1], r1[1]}; OUT = *reinterpret_cast<bf16x8*>(&w); } while (0)
    PK4(p0, 0, pa0); PK4(p0, 8, pa1); PK4(p1, 0, pa2); PK4(p1, 8, pa3);
#undef PK4
}
template <int KB, bool FOX>
__device__ __forceinline__ void qkt(f32x16& p0, f32x16& p1, const char* K_lds, int r32, int hi, const bf16x8* qr, const LAS float* nclp) {
    if constexpr (FOX) {
#pragma unroll
        for (int g = 0; g < 4; ++g) { const f32x4 n0 = *(const LAS f32x4*)(nclp + 8 * g), n1 = *(const LAS f32x4*)(nclp + 32 + 8 * g);
#pragma unroll
            for (int e = 0; e < 4; ++e) { p0[4 * g + e] = n0[e]; p1[4 * g + e] = n1[e]; } }
    } else { p0 = f32x16{}; p1 = f32x16{}; }
    const char* kb[4];
#pragma unroll
    for (int dd = 0; dd < 4; ++dd) kb[dd] = K_lds + KB * SHM_K + KSWZ(r32, (dd * 16 + hi * 8) * 2);
#pragma unroll
    for (int d0 = 0; d0 < 8; ++d0) { const char* a = kb[d0 & 3] + (d0 >> 2) * 128;
        bf16x8 b0 = *reinterpret_cast<const bf16x8*>(a);
        bf16x8 b1 = *reinterpret_cast<const bf16x8*>(a + 32 * 256);
        p0 = __builtin_amdgcn_mfma_f32_32x32x16_bf16(b0, qr[d0], p0, 0, 0, 0);
        p1 = __builtin_amdgcn_mfma_f32_32x32x16_bf16(b1, qr[d0], p1, 0, 0, 0); }
}
template <int VB>
__device__ __forceinline__ void pv_tile(f32x16* o, int vb0, bf16x8 pa0, bf16x8 pa1, bf16x8 pa2, bf16x8 pa3) {
#define TRRD(dst, off) asm volatile("ds_read_b64_tr_b16 %0, %1 offset:%2" : "=&v"(dst) : "v"(vb0), "i"(off) : "memory")
#define PV_D0(d0) do { s16x4 l0, l1, l2, l3, h0, h1, h2, h3; constexpr int b_ = VB * SHM_V + v_rd_off(d0, 0, 0); \
        TRRD(l0, b_); TRRD(h0, b_ + 2048); TRRD(l1, b_ + 4096); TRRD(h1, b_ + 6144); TRRD(l2, b_ + 8192); TRRD(h2, b_ + 10240); TRRD(l3, b_ + 12288); TRRD(h3, b_ + 14336); \
        asm volatile("s_waitcnt lgkmcnt(0)" ::: "memory"); SBAR();   \
        o[d0] = __builtin_amdgcn_mfma_f32_32x32x16_bf16(pa0, (bf16x8){l0[0], l0[1], l0[2], l0[3], h0[0], h0[1], h0[2], h0[3]}, o[d0], 0, 0, 0);   \
        o[d0] = __builtin_amdgcn_mfma_f32_32x32x16_bf16(pa1, (bf16x8){l1[0], l1[1], l1[2], l1[3], h1[0], h1[1], h1[2], h1[3]}, o[d0], 0, 0, 0);   \
        o[d0] = __builtin_amdgcn_mfma_f32_32x32x16_bf16(pa2, (bf16x8){l2[0], l2[1], l2[2], l2[3], h2[0], h2[1], h2[2], h2[3]}, o[d0], 0, 0, 0);   \
        o[d0] = __builtin_amdgcn_mfma_f32_32x32x16_bf16(pa3, (bf16x8){l3[0], l3[1], l3[2], l3[3], h3[0], h3[1], h3[2], h3[3]}, o[d0], 0, 0, 0); } while (0)
    PV_D0(0); PV_D0(1); PV_D0(2); PV_D0(3);
#undef PV_D0
#undef TRRD
}

struct BlockRef { const bf16* Q; const bf16* K; const bf16* V; bf16* O; const float* CL; int P0; int jlo; const bf16* Q2; float* GS; };
struct Seam { bf16x8 qr[8]; bf16x8 st_v0, st_v1, st_k0, st_k1; };
#define ROWK(p, k0, rr) ((p) + (size_t)((k0) + (rr)) * LDK + sc)
#define VMW() asm volatile("s_waitcnt vmcnt(0)" ::: "memory")
#define VMWN(n) asm volatile("s_waitcnt vmcnt(%0)" :: "i"(n) : "memory")
#define SLOAD_H(Kp, Vp, k0) do { S.st_v0 = load8(ROWK(Vp, k0, sr)); S.st_v1 = load8(ROWK(Vp, k0, 32 + sr));              \
                         S.st_k0 = load8(ROWK(Kp, k0, sr)); S.st_k1 = load8(ROWK(Kp, k0, 32 + sr)); } while (0)
#define SWRITE_HK(bf) do { *(bf16x8*)(K_lds + (bf) * SHM_K + kws) = S.st_k0; *(bf16x8*)(K_lds + (bf) * SHM_K + kws + 32 * 256) = S.st_k1; } while (0)
#define SWRITE_HV(bf) do { *(bf16x8*)(V_lds + (bf) * SHM_V + vst0) = S.st_v0; *(bf16x8*)(V_lds + (bf) * SHM_V + vst1) = S.st_v1; } while (0)
#define SWRITE_H(bf) do { SWRITE_HV(bf); SWRITE_HK(bf); } while (0)
__device__ __forceinline__ bf16x8 add8(bf16x8 a, bf16x8 b) {
    const u32x4 x = *reinterpret_cast<const u32x4*>(&a), y = *reinterpret_cast<const u32x4*>(&b); u32x4 w;
#pragma unroll
    for (int i = 0; i < 4; ++i) w[i] = cvtpk(__uint_as_float(x[i] << 16) + __uint_as_float(y[i] << 16), __uint_as_float(x[i] & 0xffff0000u) + __uint_as_float(y[i] & 0xffff0000u));
    return *reinterpret_cast<bf16x8*>(&w);
}
template <int LDQ, int LDK, bool QSUM = false>
__device__ __forceinline__ void attn_prime(const BlockRef& cur, char* lds, Seam& S) {
    const int tid = opaque_tid(), wid = __builtin_amdgcn_readfirstlane(tid >> 6), lane = tid & 63, r32 = lane & 31, hi = lane >> 5;
    const int sr = tid >> 4, sc = (tid & 15) * 8, kws = KSWZ(sr, sc * 2); char* K_lds = lds + 2 * SHM_V;
    const int kb0 = cur.jlo * KVBLK;
#pragma unroll
    for (int d0 = 0; d0 < 8; ++d0) { S.qr[d0] = load8(cur.Q + (size_t)(wid * QBLK + r32) * LDQ + d0 * 16 + hi * 8);
        if constexpr (QSUM) S.qr[d0] = add8(S.qr[d0], load8(cur.Q2 + (size_t)(wid * QBLK + r32) * LDQ + d0 * 16 + hi * 8)); }
    SLOAD_H(cur.K, cur.V, kb0); VMW(); SWRITE_HK(0);
    __syncthreads();
}
template <bool FOX, int LDQ, int LDK, int LDO>
__device__ __forceinline__ void attn_block(const BlockRef& cur, const BlockRef& nxt, int skv, unsigned W, char* lds, LAS float* clds, Seam& S) {
    const int tid = opaque_tid(), wid = __builtin_amdgcn_readfirstlane(tid >> 6), lane = tid & 63, r32 = lane & 31, hi = lane >> 5;
    const int j_lo = cur.jlo;
    int j_hi = (cur.P0 + QB - 1) / KVBLK + 1; if (j_hi > skv / KVBLK) j_hi = skv / KVBLK;
    const int NT = j_hi - j_lo;
    const int kbn = nxt.jlo * KVBLK;
    const int qlo = cur.P0 + wid * QBLK, qm = qlo + r32 - 4 * hi;
    char* V_lds = lds; char* K_lds = lds + 2 * SHM_V;
    float* ws = (float*)(lds + 2 * SHM_V + 2 * SHM_K) + wid * 64; float* li_l = ws, * al_l = ws + 32;
    float m_reg = -1e30f, l_reg = 0; f32x16 o[4] = {};
    const int sr = tid >> 4, sc = (tid & 15) * 8, vst0 = v_st(sr, sc), vst1 = v_st(32 + sr, sc), kws = KSWZ(sr, sc * 2);
    const int vb0 = (int)(uintptr_t)V_lds + v_rd_base(lane);
    float cq = 0.f; const LAS float* nclb = clds + 4 * hi;
    if constexpr (FOX) {
        const float cref = cur.CL[cur.P0];
        for (int i = j_lo * KVBLK + tid * 4; i < cur.P0 + QB; i += 2048) { const f32x4 v = *(const f32x4*)(cur.CL + i); *(LAS f32x4*)(clds + i) = (cref - v) * (1.0f / C2); }
        cq = cur.CL[qlo + r32] - cref;
    }
    const bf16* Kh = cur.K; const bf16* Vh = cur.V;
#define RESC(a) do { if (__any((a) < 1.f)) { if (hi == 0) al_l[r32] = (a); asm volatile("s_waitcnt lgkmcnt(0)" ::: "memory");              \
                     for (int d_ = 0; d_ < 4; ++d_) for (int r = 0; r < 16; ++r) o[d_][r] *= al_l[crow(r, hi)]; } } while (0)
#define KBASE(t) ((j_lo + (t)) * KVBLK)
#define MASKT(P0_, P1_, t) do { const int kb_ = KBASE(t); if (kb_ + KVBLK - 1 > qlo || kb_ <= qlo + QBLK - 1 - (int)W) mask_tile(P0_, P1_, qm - kb_, W); } while (0)
    f32x16 pX0, pX1; float mnX, alX; bf16x8 pa0, pa1, pa2, pa3;
    SWRITE_HV(0); SBAR();
    if (NT > 1) { SLOAD_H(Kh, Vh, KBASE(1)); }
    __syncthreads();
#define TILE_STEP(t, B) do {                                                                                      \
        SBAR(); qkt<B, FOX>(pX0, pX1, K_lds, r32, hi, S.qr, nclb + KBASE(t)); SBAR();                             \
        if ((t) + 1 < NT) { VMW(); SWRITE_H((B) ^ 1); SBAR(); if ((t) + 2 < NT) { SLOAD_H(Kh, Vh, KBASE((t) + 2)); } SBAR(); } \
        MASKT(pX0, pX1, (t)); partialSM(pX0, pX1, m_reg, mnX, alX, cq); RESC(alX);                                \
        finishSM(pX0, pX1, alX, l_reg, pa0, pa1, pa2, pa3); SBAR();                                               \
        pv_tile<B>(o, vb0, pa0, pa1, pa2, pa3);                                                                   \
        __syncthreads(); } while (0)
    int t = 0;
    for (; t + 1 < NT; t += 2) { TILE_STEP(t, 0); TILE_STEP(t + 1, 1); }
    if (t < NT) { TILE_STEP(t, 0); }
    SLOAD_H(nxt.K, nxt.V, kbn); SBAR();
#pragma unroll
    for (int d0 = 0; d0 < 8; ++d0) S.qr[d0] = load8(nxt.Q + (size_t)(wid * QBLK + r32) * LDQ + d0 * 16 + hi * 8);
    SBAR();
    if (hi == 0) li_l[r32] = l_reg; asm volatile("s_waitcnt lgkmcnt(0)" ::: "memory");
    float rli[16];
#pragma unroll
    for (int r = 0; r < 16; ++r) rli[r] = __builtin_amdgcn_rcpf(li_l[crow(r, hi)]);
    VMWN(8); SWRITE_HK(0); SBAR();
    bf16* Ow = cur.O + (size_t)(wid * QBLK) * LDO;
#pragma unroll
    for (int r = 0; r < 16; ++r) { const int orow = crow(r, hi);
        float sq = 0.f;
#pragma unroll
        for (int d0 = 0; d0 < 4; ++d0) { const float v = o[d0][r] * rli[r];
            const float vn = __shfl_xor(v, 1);
            sq += v * v;
            if ((r32 & 1) == 0) *(unsigned*)(Ow + (size_t)orow * LDO + d0 * 32 + r32) = cvtpk(v, vn); }
        if constexpr (FOX) {
            sq += __shfl_xor(sq, 1); sq += __shfl_xor(sq, 2); sq += __shfl_xor(sq, 4); sq += __shfl_xor(sq, 8); sq += __shfl_xor(sq, 16);
            if (r32 == 0) cur.GS[(size_t)(wid * QBLK + orow) * 24] = sq; } }
    __syncthreads();
#undef RESC
#undef KBASE
#undef MASKT
#undef TILE_STEP
}
#undef ROWK
#undef VMW
#undef VMWN
#undef SLOAD_H
#undef SWRITE_HK
#undef SWRITE_HV
#undef SWRITE_H
}
#define XB_TMO      128
#define XB_XCNT(j)  (256  + 64 * (j))
#define XB_XSUB(j)  (1280 + 64 * (j))
#define XB_XGEN(j)  (2304 + 64 * (j))
#define XB_TOP      3328
#define XB_TOPGEN   3392
#define XCD_BAR_WORDS 3456
#define XB_SPIN_CAP (1u << 18)

__device__ __forceinline__ unsigned xb_ld(unsigned* p)              { return __hip_atomic_load(p, __ATOMIC_RELAXED, __HIP_MEMORY_SCOPE_AGENT); }
__device__ __forceinline__ unsigned xb_add(unsigned* p, unsigned v) { return __hip_atomic_fetch_add(p, v, __ATOMIC_RELAXED, __HIP_MEMORY_SCOPE_AGENT); }
__device__ __forceinline__ unsigned xb_xcc_id() { return (unsigned)__builtin_amdgcn_s_getreg((3 << 11) | 20) & 0xFu; }
#define XB_SPIN(cond, bar) do { unsigned _sp = 0; while (cond) { __builtin_amdgcn_s_sleep(1); \
    if ((++_sp & 255u) == 0u) { if (xb_ld(&(bar)[XB_TMO])) break; if (_sp > XB_SPIN_CAP) { atomicAdd(&(bar)[XB_TMO], 1u); break; } } } } while (0)

struct XcdBarrier {
    unsigned* bar; unsigned x;
    volatile LAS unsigned* st;
};

__device__ __forceinline__ XcdBarrier xcd_barrier_post(unsigned* bar, volatile LAS unsigned* st) {
    XcdBarrier b; b.bar = bar; b.x = xb_xcc_id(); b.st = st;
    if (threadIdx.x == 0) (void)xb_add(&bar[XB_XCNT(b.x)], 1u);
    return b;
}
__device__ __forceinline__ void xcd_barrier_complete(unsigned* bar, unsigned x, unsigned& nloc, unsigned& nx) {
    const unsigned G = gridDim.x * gridDim.y * gridDim.z;
    unsigned sum, cnt, mine, sp = 0u;
    for (;;) {
        sum = 0u; cnt = 0u; mine = 0u;
#pragma unroll
        for (unsigned j = 0; j < 16; ++j) { const unsigned c = xb_ld(&bar[XB_XCNT(j)]); sum += c; cnt += (c > 0u) ? 1u : 0u; mine = (j == x) ? c : mine; }
        if (sum == G) break;
        __builtin_amdgcn_s_sleep(1);
        if ((++sp & 255u) == 0u) { if (xb_ld(&bar[XB_TMO])) break; if (sp > XB_SPIN_CAP) { atomicAdd(&bar[XB_TMO], 1u); break; } }
    }
    nloc = mine > 0u ? mine : 1u; nx = cnt > 0u ? cnt : 1u;
}

__device__ __forceinline__ void xcd_barrier(const XcdBarrier& b) {
    asm volatile("s_waitcnt vmcnt(0)" ::: "memory");
    __syncthreads();
    if (threadIdx.x == 0) {
        unsigned* bar = b.bar; asm volatile("" : "+s"(bar)); unsigned bx = b.x; asm volatile("" : "+s"(bx));
        __builtin_amdgcn_s_waitcnt(0);
        unsigned nloc = b.st[0], nx = b.st[1];
        if (nloc == 0u) { xcd_barrier_complete(bar, bx, nloc, nx); b.st[0] = nloc; b.st[1] = nx; }
        const unsigned old = xb_add(&bar[XB_XSUB(bx)], 1u);
        const unsigned gen = old / nloc;
        if (old + 1u == (gen + 1u) * nloc) {
            __builtin_amdgcn_fence(__ATOMIC_RELEASE, "agent");
            asm volatile("s_waitcnt vmcnt(0)" ::: "memory");
            const unsigned og = xb_add(&bar[XB_TOP], 1u);
            const unsigned tg = og / nx;
            if (og + 1u == (tg + 1u) * nx) xb_add(&bar[XB_TOPGEN], 1u);
            else XB_SPIN(xb_ld(&bar[XB_TOPGEN]) == tg, bar);
            __builtin_amdgcn_fence(__ATOMIC_ACQUIRE, "agent");
            xb_add(&bar[XB_XGEN(bx)], 1u);
            asm volatile("s_waitcnt vmcnt(0)" ::: "memory");
        } else {
            XB_SPIN(xb_ld(&bar[XB_XGEN(bx)]) == gen, bar);
            __builtin_amdgcn_fence(__ATOMIC_ACQUIRE, "agent");
            asm volatile("s_waitcnt vmcnt(0)" ::: "memory");
        }
    }
    __syncthreads();
}


#ifndef MK_PER_PHASE
#define MK_PER_PHASE 0
#endif
constexpr int S = 16384, DM = 2048, DFF = 5632, PIN = 4612, NZ = 4608, NZP = 4864, NMEM = 256, NLAYER = 2;
constexpr float EPS = 1e-6f;
constexpr float LOG2E = 1.4426950408889634f;
constexpr size_t MiB = 1u << 20;
constexpr size_t WS_CTL = 0;
constexpr size_t WS_BAR = 64 * 1024;
constexpr size_t WS_WF = 1 * MiB;
constexpr size_t WS_FL = 1 * MiB + 256 * 1024;
constexpr size_t WS_CL = 1 * MiB + 512 * 1024;
constexpr size_t WS_RSA = 680 * MiB, WS_RSB = 684 * MiB;
constexpr size_t WS_MEMN = 3 * MiB;
constexpr size_t WS_KVX = 5 * MiB;
constexpr size_t WS_XB = 6 * MiB;
constexpr size_t WS_HID = 70 * MiB;
constexpr size_t WS_Z = WS_HID, WS_PC = WS_HID + 144 * MiB;
constexpr size_t WS_Y = 246 * MiB;
constexpr size_t WS_QX = 310 * MiB, WS_OX = 326 * MiB;
constexpr size_t WS_GSP = 706 * MiB;
constexpr size_t WS_QX2 = 688 * MiB;
constexpr size_t WS_W = 342 * MiB;
constexpr size_t OW_GU1 = 0, OW_D1 = OW_GU1 + (size_t)2 * DFF * DM, OW_MI = OW_D1 + (size_t)DM * DFF, OW_PP = OW_MI + (size_t)NZP * DM, OW_MO = OW_PP + 1024 * 512,
                 OW_XQ = OW_MO + (size_t)DM * DM, OW_XKV = OW_XQ + 512 * DM, OW_XO = OW_XKV + 1024 * DM, OW_GU2 = OW_XO + DM * 512, OW_D2 = OW_GU2 + (size_t)2 * DFF * DM,
                 LAYER_W = OW_D2 + (size_t)DM * DFF;
constexpr size_t WS_END = WS_W + 2 * LAYER_W * 2;
static_assert(WS_END <= WS_RSA && WS_RSB + 2 * MiB <= 790 * MiB, "ws map");
constexpr size_t WS_NEED = 790 * MiB;
constexpr int LDS_BYTES = 147456;
constexpr int NPH = 1 + 16 * NLAYER;
#ifndef PH_MASK
#define PH_MASK 0x1ffff
#endif
#define PH_EN(k) (((PH_MASK) >> (k)) & 1)

typedef unsigned short bf16;
__device__ __forceinline__ float bf2f(bf16 b) { return __uint_as_float(((unsigned)b) << 16); }
__device__ __forceinline__ unsigned f2bf(float f) { unsigned u = __builtin_bit_cast(unsigned, f); return (u + 0x7fffu + ((u >> 16) & 1u)) >> 16; }
__device__ __forceinline__ unsigned pk2(float lo, float hi) { return f2bf(lo) | (f2bf(hi) << 16); }
#define LDS_WAIT() asm volatile("s_waitcnt lgkmcnt(0)" ::: "memory")
__device__ __forceinline__ float wave_sum(float v) {
#pragma unroll
    for (int o = 1; o < 64; o <<= 1) v += __shfl_xor(v, o);
    return v;
}
__device__ __forceinline__ float sigmoid_f(float g) { return __builtin_amdgcn_rcpf(1.0f + __builtin_amdgcn_exp2f(-LOG2E * g)); }

__device__ __forceinline__ void tr_item(const float* W, int ldw, int src_col0, int k0, bf16* WT, int K, int dst_row0, const float* ksc, LAS float* scr, int lane) {
    float v[32];
    const float* wp = W + (size_t)(k0 + (lane >> 5)) * ldw + src_col0 + (lane & 31);
#pragma unroll
    for (int i = 0; i < 32; ++i) v[i] = wp[(size_t)(2 * i) * ldw];
    if (ksc) {
        const float* kp = ksc + k0 + (lane >> 5);
#pragma unroll
        for (int i = 0; i < 32; ++i) v[i] *= kp[2 * i];
    }
#pragma unroll
    for (int i = 0; i < 32; ++i) scr[(2 * i + (lane >> 5)) * 33 + (lane & 31)] = v[i];
    LDS_WAIT(); asm volatile("" ::: "memory");
    const int c = lane & 7;
#pragma unroll
    for (int j = 0; j < 4; ++j) { const int n = (lane >> 3) + 8 * j; const LAS float* s = scr + (8 * c) * 33 + n;
        u32x4 o; o.x = pk2(s[0 * 33], s[1 * 33]); o.y = pk2(s[2 * 33], s[3 * 33]); o.z = pk2(s[4 * 33], s[5 * 33]); o.w = pk2(s[6 * 33], s[7 * 33]);
        *(u32x4*)(WT + (size_t)(dst_row0 + n) * K + k0 + 8 * c) = o; }
    LDS_WAIT(); asm volatile("" ::: "memory");
}
__device__ __forceinline__ void tr_job(int r, const float* W, int ldw, int K, int Ndst, bf16* WT, int row_off, const float* ksc, int cmode, LAS float* scr, int lane) {
    const int nblk = Ndst / 32, kb = r / nblk, nb = r % nblk, n0 = 32 * nb;
    int src = n0, dst = row_off + n0;
    if (cmode == 1) dst = 256 * (n0 >> 7) + (n0 & 127);
    else if (cmode == 2) dst = 256 * (n0 >> 7) + 128 + (n0 & 127);
    else if (cmode == 3) { src = n0 + (n0 >= 3072 ? 4 : 0);
        if (n0 >= 512 && n0 < 1024) dst = row_off + 512 + 256 * ((n0 - 512) >> 7) + ((n0 - 512) & 127);
        else if (n0 >= 1024 && n0 < 1536) dst = row_off + 512 + 256 * ((n0 - 1024) >> 7) + 128 + ((n0 - 1024) & 127);
        else if (n0 >= 3584 && n0 < 4096) dst = row_off + 3584 + 256 * ((n0 - 3584) >> 7) + ((n0 - 3584) & 127);
        else if (n0 >= 4096 && n0 < 4608) dst = row_off + 3584 + 256 * ((n0 - 4096) >> 7) + 128 + ((n0 - 4096) & 127); }
    tr_item(W, ldw, src, 64 * kb, WT, K, dst, ksc, scr, lane);
}

template <int MODE>
__device__ __forceinline__ void norm_rows(const float* X, bf16* XB, const float* gain, float* OUT, const float* WF, float* FL, int nrows, int gw, int NGW, int lane) {
    f32x4 gv[8];
    if (MODE == 2) {
#pragma unroll
        for (int j = 0; j < 8; ++j) gv[j] = ((const f32x4*)gain + lane)[64 * j];
    }
    for (int row = gw; row < nrows; row += NGW) {
        const f32x4* xr = (const f32x4*)(X + (size_t)row * DM) + lane;
        f32x4 v[8]; float ss = 0.f;
#pragma unroll
        for (int j = 0; j < 8; ++j) v[j] = xr[64 * j];
        __builtin_amdgcn_sched_barrier(0);
#pragma unroll
        for (int j = 0; j < 8; ++j) ss += (v[j].x * v[j].x + v[j].y * v[j].y) + (v[j].z * v[j].z + v[j].w * v[j].w);
        const float sst = wave_sum(ss); const float rstd = MODE == 3 ? 1.0f : 1.0f / sqrtf(sst * (1.0f / DM) + EPS);
        if (MODE == 3 && lane < 32) OUT[(size_t)row * 32 + lane] = lane == 0 ? sst : 0.f;
        if (MODE == 2) {
            f32x4* orow = (f32x4*)(OUT + (size_t)row * DM) + lane;
#pragma unroll
            for (int j = 0; j < 8; ++j) orow[64 * j] = v[j] * rstd * gv[j];
        } else {
            unsigned long long* o8 = (unsigned long long*)(XB + (size_t)row * DM) + lane;
#pragma unroll
            for (int j = 0; j < 8; ++j) o8[64 * j] = (unsigned long long)pk2(v[j].x * rstd, v[j].y * rstd) | ((unsigned long long)pk2(v[j].z * rstd, v[j].w * rstd) << 32);
            if (MODE == 1) {
#pragma unroll
                for (int h = 0; h < 4; ++h) { const f32x4* wr = (const f32x4*)(WF + h * DM) + lane; float d = 0.f;
#pragma unroll
                    for (int j = 0; j < 8; ++j) { const f32x4 w = wr[64 * j]; d += (v[j].x * w.x + v[j].y * w.y) + (v[j].z * w.z + v[j].w * w.w); }
                    d = wave_sum(d); if (lane == 0) FL[row * 4 + h] = d * rstd; }
            }
        }
    }
}
__device__ __forceinline__ void split_rows(const float* X, bf16* XH, float* RSP, int gw, int NGW, int lane) {
    for (int row = gw; row < S; row += NGW) {
        const f32x4* xr = (const f32x4*)(X + (size_t)row * DM) + lane;
        f32x4 v[8]; float ss = 0.f;
#pragma unroll
        for (int j = 0; j < 8; ++j) v[j] = xr[64 * j];
        __builtin_amdgcn_sched_barrier(0);
        unsigned long long* oh = (unsigned long long*)(XH + (size_t)row * DM) + lane;
#pragma unroll
        for (int j = 0; j < 8; ++j) { ss += (v[j].x * v[j].x + v[j].y * v[j].y) + (v[j].z * v[j].z + v[j].w * v[j].w);
            const unsigned h0 = pk2(v[j].x, v[j].y), h1 = pk2(v[j].z, v[j].w);
            oh[64 * j] = (unsigned long long)h0 | ((unsigned long long)h1 << 32); }
        const float sst = wave_sum(ss);
        if (lane < 32) RSP[(size_t)row * 32 + lane] = lane == 0 ? sst : 0.f;
    }
}
__device__ __forceinline__ void final_rows(const bf16* XH, const float* RSP, const float* gain, float* OUT, int gw, int NGW, int lane) {
    f32x4 gv[4][2];
#pragma unroll
    for (int j = 0; j < 4; ++j) { gv[j][0] = *(const f32x4*)(gain + 8 * (lane + 64 * j)); gv[j][1] = *(const f32x4*)(gain + 8 * (lane + 64 * j) + 4); }
    for (int row = gw; row < S; row += NGW) {
        const u32x4* xh = (const u32x4*)(XH + (size_t)row * DM) + lane;
        u32x4 wh[4];
#pragma unroll
        for (int j = 0; j < 4; ++j) wh[j] = xh[64 * j];
        const float p = RSP[(size_t)row * 32 + (lane & 31)];
        __builtin_amdgcn_sched_barrier(0);
        const float rstd = 1.0f / sqrtf(wave_sum(lane < 32 ? p : 0.f) * (1.0f / DM) + EPS);
        float* orow = OUT + (size_t)row * DM;
#pragma unroll
        for (int j = 0; j < 4; ++j) { const u32x4 q = wh[j];
            f32x4 a = {__uint_as_float(q.x << 16), __uint_as_float(q.x & 0xffff0000u), __uint_as_float(q.y << 16), __uint_as_float(q.y & 0xffff0000u)};
            f32x4 b = {__uint_as_float(q.z << 16), __uint_as_float(q.z & 0xffff0000u), __uint_as_float(q.w << 16), __uint_as_float(q.w & 0xffff0000u)};
            *(f32x4*)(orow + 8 * (lane + 64 * j)) = a * rstd * gv[j][0]; *(f32x4*)(orow + 8 * (lane + 64 * j) + 4) = b * rstd * gv[j][1]; }
    }
}
__device__ __forceinline__ void group_norm_rows(bf16* Y, int gw, int NGW, int lane) {
    for (int row = gw; row < S; row += 2 * NGW) {
        u32x4* yr0 = (u32x4*)(Y + (size_t)row * DM) + lane; u32x4* yr1 = (u32x4*)(Y + (size_t)(row + NGW) * DM) + lane;
        u32x4 w[2][3];
#pragma unroll
        for (int g = 0; g < 3; ++g) { w[0][g] = yr0[64 * g]; w[1][g] = yr1[64 * g]; }
        __builtin_amdgcn_sched_barrier(0);
#pragma unroll
        for (int r = 0; r < 2; ++r)
#pragma unroll
            for (int g = 0; g < 3; ++g) { const u32x4 q = w[r][g]; float f[8];
                f[0] = __uint_as_float(q.x << 16); f[1] = __uint_as_float(q.x & 0xffff0000u); f[2] = __uint_as_float(q.y << 16); f[3] = __uint_as_float(q.y & 0xffff0000u);
                f[4] = __uint_as_float(q.z << 16); f[5] = __uint_as_float(q.z & 0xffff0000u); f[6] = __uint_as_float(q.w << 16); f[7] = __uint_as_float(q.w & 0xffff0000u);
                float ss = 0.f;
#pragma unroll
                for (int e = 0; e < 8; ++e) ss += f[e] * f[e];
                const float rstd = 1.0f / sqrtf(wave_sum(ss) * (1.0f / 512.0f) + EPS);
                u32x4 o; o.x = pk2(f[0] * rstd, f[1] * rstd); o.y = pk2(f[2] * rstd, f[3] * rstd); o.z = pk2(f[4] * rstd, f[5] * rstd); o.w = pk2(f[6] * rstd, f[7] * rstd);
                (r ? yr1 : yr0)[64 * g] = o; }
    }
}

template <int PM>
__device__ __forceinline__ void ew_post(LAS float* buf, bf16* dst, int ld, const float* lg, const float* lb, int wid, int lane) {
    f32x4 g0 = {1, 1, 1, 1}, g1 = g0, b0 = {0, 0, 0, 0}, b1 = b0;
    if (PM == 1) { g0 = *(const f32x4*)(lg + 8 * lane); g1 = *(const f32x4*)(lg + 8 * lane + 4); b0 = *(const f32x4*)(lb + 8 * lane); b1 = *(const f32x4*)(lb + 8 * lane + 4); }
#pragma unroll
    for (int q = 0; q < 4; ++q) { const int i = wid * 4 + q;
        f32x4 v0 = *(const LAS f32x4*)(buf + i * 512 + 8 * lane), v1 = *(const LAS f32x4*)(buf + i * 512 + 8 * lane + 4);
        if (PM == 1) {
            const float mean = wave_sum((v0.x + v0.y) + (v0.z + v0.w) + (v1.x + v1.y) + (v1.z + v1.w)) * (1.0f / 512.0f);
            v0 = v0 - mean; v1 = v1 - mean;
            const float var = wave_sum((v0.x * v0.x + v0.y * v0.y) + (v0.z * v0.z + v0.w * v0.w) + (v1.x * v1.x + v1.y * v1.y) + (v1.z * v1.z + v1.w * v1.w)) * (1.0f / 512.0f);
            const float rstd = 1.0f / sqrtf(var + EPS);
            v0 = v0 * rstd * g0 + b0; v1 = v1 * rstd * g1 + b1;
            v0.x *= sigmoid_f(v0.x); v0.y *= sigmoid_f(v0.y); v0.z *= sigmoid_f(v0.z); v0.w *= sigmoid_f(v0.w);
            v1.x *= sigmoid_f(v1.x); v1.y *= sigmoid_f(v1.y); v1.z *= sigmoid_f(v1.z); v1.w *= sigmoid_f(v1.w);
        } else if (PM == 2) {
            const float ss = wave_sum((v0.x * v0.x + v0.y * v0.y) + (v0.z * v0.z + v0.w * v0.w) + (v1.x * v1.x + v1.y * v1.y) + (v1.z * v1.z + v1.w * v1.w)) * (1.0f / 512.0f);
            const float rstd = 1.0f / sqrtf(ss + EPS);
            v0 = v0 * rstd; v1 = v1 * rstd;
        }
        u32x4 o; o.x = pk2(v0.x, v0.y); o.y = pk2(v0.z, v0.w); o.z = pk2(v1.x, v1.y); o.w = pk2(v1.z, v1.w);
        *(u32x4*)(dst + (size_t)i * ld + 8 * lane) = o; }
}
template <int NC, int NIT>
__device__ __forceinline__ void ew_stage(const bf16* Z, int col0, int row_first, int nrows, LAS unsigned char* stg, int tid) {
    constexpr int CPR = NC / 8;
    u32x4 v[NIT];
#pragma unroll
    for (int it = 0; it < NIT; ++it) { int c = tid + it * 512; if (c >= nrows * CPR) c = nrows * CPR - 1; const int r = c / CPR, cc = c % CPR; int tt = row_first + r; tt = tt < 0 ? 0 : tt;
        v[it] = *(const u32x4*)(Z + (size_t)tt * NZ + col0 + cc * 8); }
    __builtin_amdgcn_sched_barrier(0);
#pragma unroll
    for (int it = 0; it < NIT; ++it) { int c = tid + it * 512; if (c >= nrows * CPR) c = nrows * CPR - 1;
        *(LAS u32x4*)(stg + (size_t)c * 16) = v[it]; }
}
__device__ __forceinline__ void ew_chunk(const bf16* Z, bf16* PC, bf16* Y, const float* dw_w, const float* dw_b, const float* ln_g, const float* ln_b, const float* sc_w,
                                         float* NRM, LAS float* buf, int chunk, int tid, int wid, int lane) {
    const int t0 = chunk * 32, ch = tid;
    LAS unsigned char* stg = (LAS unsigned char*)buf + 65536; const LAS bf16* st16 = (const LAS bf16*)stg;
    {
        const int p = tid >> 1, isK = p >> 7, tok = (p >> 2) & 31, hd = p & 3;
        const bf16* src = Z + (size_t)(t0 + tok) * NZ + 1536 + isK * 512 + hd * 128 + (tid & 1) * 64;
        u32x4 w8[8];
#pragma unroll
        for (int c = 0; c < 8; ++c) w8[c] = *(const u32x4*)(src + 8 * c);
        __builtin_amdgcn_sched_barrier(0);
        float ss = 0.f;
#pragma unroll
        for (int c = 0; c < 8; ++c) { const u32x4 w = w8[c];
            const float f0 = __uint_as_float(w.x << 16), f1 = __uint_as_float(w.x & 0xffff0000u), f2 = __uint_as_float(w.y << 16), f3 = __uint_as_float(w.y & 0xffff0000u);
            const float f4 = __uint_as_float(w.z << 16), f5 = __uint_as_float(w.z & 0xffff0000u), f6 = __uint_as_float(w.w << 16), f7 = __uint_as_float(w.w & 0xffff0000u);
            ss += (f0 * f0 + f1 * f1) + (f2 * f2 + f3 * f3) + (f4 * f4 + f5 * f5) + (f6 * f6 + f7 * f7); }
        ss += __shfl_xor(ss, 1);
        ss = fmaxf(ss, __shfl_xor(ss, 8)); ss = fmaxf(ss, __shfl_xor(ss, 16)); ss = fmaxf(ss, __shfl_xor(ss, 32));
        if (lane < 8 && !(lane & 1)) NRM[(isK * 4 + hd) * 2048 + chunk * 4 + (wid & 3)] = ss;
    }
    {
        float seq[62];
        ew_stage<512, 8>(Z, 512, t0 - 30, 62, stg, tid);
        __syncthreads();
#pragma unroll
        for (int i = 0; i < 62; ++i) { const int tt = t0 - 30 + i; seq[i] = (tt < 0 ? 0.f : 1.f) * bf2f(st16[i * 512 + ch]); }
        __syncthreads();
        float cv[32], wk[31]; const float b = dw_b[ch];
#pragma unroll
        for (int k = 0; k < 31; ++k) wk[k] = dw_w[k * 512 + ch];
        __builtin_amdgcn_sched_barrier(0);
#pragma unroll
        for (int i = 0; i < 32; ++i) cv[i] = b;
#pragma unroll
        for (int k = 0; k < 31; ++k) {
#pragma unroll
            for (int i = 0; i < 32; ++i) cv[i] = fmaf(wk[k], seq[i + k], cv[i]); }
#pragma unroll
        for (int i = 0; i < 32; ++i) buf[i * 512 + ch] = cv[i];
    }
    __syncthreads();
    ew_post<1>(buf, PC + (size_t)(S + t0) * 512, 512, ln_g, ln_b, wid, lane);
    {
        float m[34];
        ew_stage<512, 5>(Z, 3584, t0 - 2, 34, stg, tid);
        __syncthreads();
#pragma unroll
        for (int i = 0; i < 34; ++i) { const int tt = t0 - 2 + i; m[i] = (tt < 0 ? 0.f : 1.f) * bf2f(st16[i * 512 + ch]); }
        __syncthreads();
        ew_stage<512, 4>(Z, 3072, t0, 32, stg, tid);
        __syncthreads();
        const float w0 = sc_w[ch], w1 = sc_w[512 + ch], w2 = sc_w[1024 + ch];
#pragma unroll
        for (int i = 0; i < 32; ++i) buf[i * 512 + ch] = bf2f(st16[i * 512 + ch]) * (w0 * m[i] + w1 * m[i + 1] + w2 * m[i + 2]);
    }
    __syncthreads();
    ew_post<2>(buf, Y + (size_t)t0 * DM + 1536, DM, nullptr, nullptr, wid, lane);
    {
        float seq[47];
        ew_stage<512, 6>(Z, 0, t0 - 15, 47, stg, tid);
        __syncthreads();
#pragma unroll
        for (int i = 0; i < 47; ++i) { const int tt = t0 - 15 + i; seq[i] = (tt < 0 ? 0.f : 1.f) * bf2f(st16[i * 512 + ch]); }
        const int w = 2 << (wid >> 1);
#pragma unroll
        for (int i = 0; i < 32; ++i) { float s = 0.f;
#pragma unroll
            for (int j = 0; j < 16; ++j) s += (j < w) ? seq[15 + i - j] : 0.f;
            const int cnt = (t0 + i + 1) < w ? (t0 + i + 1) : w;
            buf[i * 512 + ch] = s / (float)cnt - seq[15 + i]; }
    }
    __syncthreads();
    ew_post<0>(buf, PC + (size_t)t0 * 512, 512, nullptr, nullptr, wid, lane);
    __syncthreads();
}
__device__ __forceinline__ void scan_head(const float* FL, float bias, float* CLh, int h, LAS unsigned char* lds, int tid) {
    LAS float* sl = (LAS float*)lds;
    LAS double* sd = (LAS double*)(lds + 67584);
    float ls[32];
#pragma unroll
    for (int i = 0; i < 32; ++i) ls[i] = FL[(size_t)(i * 512 + tid) * 4 + h];
    __builtin_amdgcn_sched_barrier(0);
#pragma unroll
    for (int i = 0; i < 32; ++i) { const int e = i * 512 + tid; const float x = ls[i] + bias; const float ex = __builtin_amdgcn_exp2f(-fabsf(x) * LOG2E);
        sl[e + (e >> 5)] = fminf(x, 0.f) * LOG2E - __builtin_amdgcn_logf(1.0f + ex); }
    __syncthreads();
    double s = 0.0;
#pragma unroll
    for (int i = 0; i < 32; ++i) { ls[i] = sl[tid * 33 + i]; s += (double)ls[i]; }
    sd[tid] = s; __syncthreads();
    for (int off = 1; off < 512; off <<= 1) { const double v = tid >= off ? sd[tid - off] : 0.0; __syncthreads(); sd[tid] += v; __syncthreads(); }
    double run = tid ? sd[tid - 1] : 0.0;
#pragma unroll
    for (int i = 0; i < 32; ++i) { run += (double)ls[i]; sl[tid * 33 + i] = (float)run; }
    __syncthreads();
#pragma unroll
    for (int i = 0; i < 32; ++i) { const int e = i * 512 + tid; CLh[e] = sl[e + (e >> 5)]; }
    __syncthreads();
}

__device__ __forceinline__ att::BlockRef fox_block(const bf16* Z, bf16* Y, const float* CL, float* GSP, int h, int x, int jlo) {
    att::BlockRef b; b.Q = Z + (size_t)(x * 256) * NZ + 1536 + h * 128; b.K = Z + 2048 + h * 128; b.V = Z + 2560 + h * 128; b.O = Y + (size_t)(x * 256) * DM + 1024 + h * 128;
    b.CL = CL + (size_t)h * S; b.P0 = x * 256; b.jlo = jlo; b.Q2 = nullptr; b.GS = GSP + (size_t)(x * 256) * 24 + 16 + h; return b;
}
#define CAS __attribute__((address_space(4)))
struct Args { const float* in[30]; float* out; unsigned char* ws; int ph_lo, ph_hi; };

__global__ void __launch_bounds__(512, 2) fwd_kernel(Args a) {
    extern __shared__ __attribute__((aligned(16))) unsigned char lds[];
    LAS unsigned char* ldsl = (LAS unsigned char*)lds;
    cg::grid_group grid = cg::this_grid();
    const int G = gridDim.x;
    volatile LAS unsigned* stw = (volatile LAS unsigned*)(ldsl + LDS_BYTES - 64);
    if (threadIdx.x < 2) stw[threadIdx.x] = 0u;
    __syncthreads();
    const XcdBarrier xbar = xcd_barrier_post((unsigned*)(a.ws + WS_BAR), stw);
    for (int ph = a.ph_lo; ph < a.ph_hi; ++ph) {
        const int tid = opaque_tid(), lane = tid & 63, wid = __builtin_amdgcn_readfirstlane(tid >> 6);
        int bid = blockIdx.x; asm volatile("" : "+s"(bid));
        const CAS Args* ap = (const CAS Args*)__builtin_amdgcn_kernarg_segment_ptr(); asm volatile("" : "+s"(ap));
        unsigned char* ws = ap->ws; float* X = ap->out;
        const int gw = bid * 8 + wid, NGW = G * 8;
        float* FL = (float*)(ws + WS_FL); float* CL = (float*)(ws + WS_CL);
        bf16* MEMN = (bf16*)(ws + WS_MEMN); bf16* KVX = (bf16*)(ws + WS_KVX); bf16* XB = (bf16*)(ws + WS_XB); bf16* HID = (bf16*)(ws + WS_HID);
        bf16* Z = (bf16*)(ws + WS_Z); bf16* PC = (bf16*)(ws + WS_PC); bf16* Y = (bf16*)(ws + WS_Y); bf16* QX = (bf16*)(ws + WS_QX); bf16* OX = (bf16*)(ws + WS_OX); bf16* QX2 = (bf16*)(ws + WS_QX2); float* GSP = (float*)(ws + WS_GSP);
        bf16* WALL = (bf16*)(ws + WS_W);
        float* NRM = (float*)(ws + WS_CTL);
        float* RSA = (float*)(ws + WS_RSA); float* RSB = (float*)(ws + WS_RSB);
        LAS float* rsl = (LAS float*)(ldsl + 131072);
        if (ph == 0) { if constexpr (PH_EN(16)) {
            LAS float* scr = (LAS float*)(ldsl + wid * 16384);
            constexpr int I_F = (DM / 64) * (DFF / 32), I_MI = (DM / 64) * (NZ / 32), I_PW = 8 * 16, I_MO = 32 * 64, I_X = 32 * 16, I_XO = 8 * 64;
            constexpr int I_FG = DM / 64;
            constexpr int I_LAYER = 6 * I_F + I_MI + I_FG + I_PW + I_MO + 3 * I_X + I_XO;
            for (int it = gw; it < NLAYER * I_LAYER; it += NGW) {
                const int l = it / I_LAYER; int r = it % I_LAYER; bf16* WL = WALL + (size_t)l * LAYER_W;
                const size_t oF = (size_t)l * DM * DFF;
                if (r < I_F) { tr_job(r, ap->in[3] + oF, DFF, DM, DFF, WL + OW_GU1, 0, ap->in[2] + l * DM, 1, scr, lane); continue; } r -= I_F;
                if (r < I_F) { tr_job(r, ap->in[4] + oF, DFF, DM, DFF, WL + OW_GU1, 0, ap->in[2] + l * DM, 2, scr, lane); continue; } r -= I_F;
                if (r < I_F) { tr_job(r, ap->in[5] + oF, DM, DFF, DM, WL + OW_D1, 0, nullptr, 0, scr, lane); continue; } r -= I_F;
                if (r < I_F) { tr_job(r, ap->in[26] + oF, DFF, DM, DFF, WL + OW_GU2, 0, ap->in[25] + l * DM, 1, scr, lane); continue; } r -= I_F;
                if (r < I_F) { tr_job(r, ap->in[27] + oF, DFF, DM, DFF, WL + OW_GU2, 0, ap->in[25] + l * DM, 2, scr, lane); continue; } r -= I_F;
                if (r < I_F) { tr_job(r, ap->in[28] + oF, DM, DFF, DM, WL + OW_D2, 0, nullptr, 0, scr, lane); continue; } r -= I_F;
                if (r < I_MI) { tr_job(r, ap->in[7] + (size_t)l * DM * PIN, PIN, DM, NZ, WL + OW_MI, 0, ap->in[6] + l * DM, 3, scr, lane); continue; } r -= I_MI;
                if (r < I_FG) { tr_item(ap->in[7] + (size_t)l * DM * PIN, PIN, 3072, 64 * r, WL + OW_MI, DM, NZ, ap->in[6] + l * DM, scr, lane); continue; } r -= I_FG;
                if (r < I_PW) { tr_job(r, ap->in[14] + (size_t)l * 512 * 512, 512, 512, 512, WL + OW_PP, 512, nullptr, 0, scr, lane); continue; } r -= I_PW;
                if (r < I_MO) { tr_job(r, ap->in[18] + (size_t)l * DM * DM, DM, DM, DM, WL + OW_MO, 0, ap->in[17] + l * DM, 0, scr, lane); continue; } r -= I_MO;
                if (r < I_X) { tr_job(r, ap->in[21] + (size_t)l * DM * 512, 512, DM, 512, WL + OW_XQ, 0, ap->in[19] + l * DM, 0, scr, lane); continue; } r -= I_X;
                if (r < I_X) { tr_job(r, ap->in[22] + (size_t)l * DM * 512, 512, DM, 512, WL + OW_XKV, 0, ap->in[20] + l * DM, 0, scr, lane); continue; } r -= I_X;
                if (r < I_X) { tr_job(r, ap->in[23] + (size_t)l * DM * 512, 512, DM, 512, WL + OW_XKV, 512, ap->in[20] + l * DM, 0, scr, lane); continue; } r -= I_X;
                tr_job(r, ap->in[24] + (size_t)l * 512 * DM, DM, 512, DM, WL + OW_XO, 0, nullptr, 0, scr, lane);
            }
            for (int idx = bid * 512 + tid; idx < NLAYER * 512 * 512; idx += G * 512) { const int l = idx >> 18, n = (idx >> 9) & 511, k = idx & 511;
                float v = 0.f; if ((n >> 7) == (k >> 7)) v = ap->in[8][(size_t)l * 65536 + (size_t)(n >> 7) * 16384 + (k & 127) * 128 + (n & 127)] * ap->in[9][l * 512 + n];
                (WALL + (size_t)l * LAYER_W + OW_PP)[n * 512 + k] = (bf16)f2bf(v); }
            norm_rows<0>(ap->in[1], MEMN, nullptr, nullptr, nullptr, nullptr, NMEM, gw, NGW, lane);
            split_rows(ap->in[0], XB, RSB, gw, NGW, lane);
        } } else {
            const int l = (ph - 1) >> 4, sub = (ph - 1) & 15;
            if (sub == 2 || sub == 6 || sub == 8 || sub == 12 || (sub == 15 && l + 1 < NLAYER)) continue;
            bf16* WL = WALL + (size_t)l * LAYER_W;
            switch (sub) {
            case 0: case 13: if constexpr (PH_EN(0)) {
                pg8::Gemm g{XB, WL + (sub == 0 ? OW_GU1 : OW_GU2), S, 2 * DFF, DM}; pg8::StaticOrder So; So.init(S, 2 * DFF, G, bid);
                pg8::EpiSwiGLU E{HID, DFF, sub == 0 ? RSB : RSA, rsl};
                pg8::gemm_phase<pg8::EpiSwiGLU, pg8::StaticOrder, true, true>(ldsl, g, So, E);
            } break;
            case 1: case 14: if constexpr (PH_EN(1)) {
                pg8::Gemm g{HID, WL + (sub == 1 ? OW_D1 : OW_D2), S, DM, DFF}; pg8::StaticOrder So; So.init(S, DM, G, bid);
                pg8::EpiResid<false> E{XB, sub == 1 ? RSA : RSB, 0.5f, 0}; pg8::gemm_phase<pg8::EpiResid<false>, pg8::StaticOrder, true, true>(ldsl, g, So, E);
            } break;
            case 2: break;
            case 3: if constexpr (PH_EN(3)) {
                pg8::Gemm g{XB, WL + OW_MI, S, NZP, DM}; pg8::StaticOrder So; So.init(S, NZP, G, bid);
                pg8::EpiBf<0> E{Z, NZ, RSA, rsl, -1, FL, NZ / 256, nullptr, 1};
                pg8::gemm_phase<pg8::EpiBf<0>, pg8::StaticOrder, true, true>(ldsl, g, So, E);
                if (bid >= 192 && bid < 196) {
                    __syncthreads();
                    pg8::Gemm g2{MEMN, WL + OW_XKV, NMEM, 1024, DM, 0}; pg8::StaticOrder S2; S2.init(NMEM, 1024, 64, bid - 192);
                    pg8::EpiBf<0> E2{KVX, 1024, nullptr, rsl, -1, nullptr, 0};
                    pg8::gemm_phase<pg8::EpiBf<0>, pg8::StaticOrder, true, true>(ldsl, g2, S2, E2);
                }
            } break;
            case 4: if constexpr (PH_EN(4)) {
                if (bid < 4) scan_head(FL, ap->in[15][l * 4 + bid], CL + (size_t)bid * S, bid, ldsl, tid);
                for (int c0 = 2 * bid; c0 < S / 32; c0 += 2 * G)
                for (int c = c0; c < c0 + 2; ++c) {
                    const int t2 = opaque_tid();
                    ew_chunk(Z, PC, Y, ap->in[10] + l * 31 * 512, ap->in[11] + l * 512, ap->in[12] + l * 512, ap->in[13] + l * 512, ap->in[16] + l * 3 * 512, NRM, (LAS float*)ldsl, c, t2, __builtin_amdgcn_readfirstlane(t2 >> 6), t2 & 63);
                }
            } break;
            case 5: if constexpr (PH_EN(5)) {
                { pg8::Gemm g{PC, WL + OW_PP, 2 * S, 1024, 512}; pg8::PPOrder So{G, bid}; pg8::EpiBf<1> E{Y, DM, nullptr, rsl, -1, nullptr, 0, GSP};
                  pg8::gemm_phase<pg8::EpiBf<1>, pg8::PPOrder, true, true>(ldsl, g, So, E); }
                __syncthreads();
                for (int item = bid; item < 256; item += G) {
                    const int h = item & 3, qb = item >> 2;
                    float km, qm = 0.f;
                    { const f32x4 kv = *(const f32x4*)(NRM + (size_t)(4 + h) * 2048 + 4 * tid); km = fmaxf(fmaxf(kv[0], kv[1]), fmaxf(kv[2], kv[3]));
                      if (tid < 8) { const f32x4 qv = *(const f32x4*)(NRM + (size_t)h * 2048 + 32 * qb + 4 * tid); qm = fmaxf(fmaxf(qv[0], qv[1]), fmaxf(qv[2], qv[3])); }
#pragma unroll
                      for (int o = 1; o < 64; o <<= 1) { km = fmaxf(km, __shfl_xor(km, o)); qm = fmaxf(qm, __shfl_xor(qm, o)); }
                      LAS float* red = (LAS float*)(ldsl + 139264);
                      if (lane == 0) { red[wid] = km; red[8 + wid] = qm; }
                      __syncthreads();
#pragma unroll
                      for (int w8 = 0; w8 < 8; ++w8) { km = fmaxf(km, red[w8]); qm = fmaxf(qm, red[8 + w8]); } }
                    const float qk = 2.0f * att::C2 * 1.001f * sqrtf(qm * km);
                    const float* CLh = CL + (size_t)h * S;
                    const bool skip = (tid < qb * 4) && (CLh[qb * 256] - CLh[64 * tid + 63] + qk < -48.0f);
                    int jlo;
                    { LAS int* cnt8 = (LAS int*)(ldsl + 139264 + 128);
                      const int wc_ = __popcll(__ballot(skip)); if (lane == 0) cnt8[wid] = wc_;
                      __syncthreads();
                      int tot = 0;
#pragma unroll
                      for (int w8 = 0; w8 < 8; ++w8) tot += cnt8[w8];
                      jlo = __builtin_amdgcn_readfirstlane(tot); }
                    att::Seam Sm;
                    const att::BlockRef cur = fox_block(Z, Y, CL, GSP, h, qb, jlo);
                    att::attn_prime<NZ, NZ>(cur, (char*)lds, Sm);
                    att::attn_block<true, NZ, NZ, DM>(cur, cur, S, 0x40000000u, (char*)lds, (LAS float*)(ldsl + att::CLDS_OFF), Sm);
                    asm volatile("s_waitcnt vmcnt(0)" ::: "memory"); __syncthreads();
                }
            } break;
            case 6: if constexpr (PH_EN(6)) group_norm_rows(Y, gw, NGW, lane); break;
            case 7: if constexpr (PH_EN(7)) {
                pg8::Gemm g{Y, WL + OW_MO, S, DM, DM}; pg8::StaticOrder So; So.init(S, DM, G, bid);
                pg8::EpiResid<true> E{XB, RSB, 1.0f, 0, GSP, (LAS float*)(ldsl + 131072 + 1024), -1};
                pg8::gemm_phase<pg8::EpiResid<true>, pg8::StaticOrder, true, true>(ldsl, g, So, E);
            } break;
            case 8: case 12: if constexpr (PH_EN(8)) norm_rows<0>(X, XB, nullptr, nullptr, nullptr, nullptr, S, gw, NGW, lane); break;
            case 9: if constexpr (PH_EN(9)) {
                const int kh = bid >> 7;
                pg8::Gemm g{XB + kh * 1024, WL + OW_XQ + kh * 1024, S, 512, 1024, DM}; pg8::StaticOrder So; So.init(S, 512, 128, bid & 127);
                pg8::EpiBf<0> E{kh ? QX2 : QX, 512, RSB, rsl, -1, nullptr, 0};
                pg8::gemm_phase<pg8::EpiBf<0>, pg8::StaticOrder, true, true>(ldsl, g, So, E);
            } break;
            case 10: if constexpr (PH_EN(10)) {
                for (int item = bid; item < 256; item += G) {
                    const int h = item & 3, qb = item >> 2;
                    att::BlockRef b0;
                    b0.Q = QX + (size_t)(qb * 256) * 512 + h * 128; b0.K = KVX + h * 128; b0.V = KVX + 512 + h * 128; b0.O = OX + (size_t)(qb * 256) * 512 + h * 128;
                    b0.CL = nullptr; b0.P0 = 256; b0.jlo = 0; b0.Q2 = QX2 + (size_t)(qb * 256) * 512 + h * 128; b0.GS = nullptr;
                    att::Seam Sm;
                    att::attn_prime<512, 1024, true>(b0, (char*)lds, Sm);
                    att::attn_block<false, 512, 1024, 512>(b0, b0, NMEM, 0x40000000u, (char*)lds, (LAS float*)(ldsl + att::CLDS_OFF), Sm);
                    asm volatile("s_waitcnt vmcnt(0)" ::: "memory"); __syncthreads();
                }
            } break;
            case 11: if constexpr (PH_EN(11)) {
                pg8::Gemm g{OX, WL + OW_XO, S, DM, 512}; pg8::StaticOrder So; So.init(S, DM, G, bid);
                pg8::EpiResid<false> E{XB, RSA, 1.0f, 0};
                pg8::gemm_phase<pg8::EpiResid<false>, pg8::StaticOrder, true, true>(ldsl, g, So, E);
            } break;
            case 15: if constexpr (PH_EN(15)) {
                if (l + 1 < NLAYER) norm_rows<0>(X, XB, nullptr, nullptr, nullptr, nullptr, S, gw, NGW, lane);
                else final_rows(XB, RSB, ap->in[29], X, gw, NGW, lane); }
                break;
            }
        }
        if (ph + 1 < a.ph_hi) { if (ph == 0) grid.sync(); else xcd_barrier(xbar); }
    }
}

extern "C" void kernel_launch(void* const* d_in, const int* in_sizes, int n_in, void* d_out, int out_size, void* d_ws, size_t ws_size, hipStream_t stream) {
    static int grid = 0;
    if (grid == 0) {
        if (n_in != 30 || in_sizes[0] != S * DM || out_size != S * DM || ws_size < WS_NEED) { fprintf(stderr, "kernel_launch: unexpected shapes (n_in %d, in0 %d, out %d, ws %zu)\n", n_in, n_in > 0 ? in_sizes[0] : -1, out_size, ws_size); grid = -1; return; }
        int dev = 0, cus = 0, per_cu = 0;
        if (hipGetDevice(&dev) != hipSuccess || hipDeviceGetAttribute(&cus, hipDeviceAttributeMultiprocessorCount, dev) != hipSuccess) { grid = -1; return; }
        if (hipFuncSetAttribute((const void*)fwd_kernel, hipFuncAttributeMaxDynamicSharedMemorySize, LDS_BYTES) != hipSuccess) { fprintf(stderr, "kernel_launch: hipFuncSetAttribute failed\n"); grid = -1; return; }
        if (hipOccupancyMaxActiveBlocksPerMultiprocessor(&per_cu, (const void*)fwd_kernel, 512, LDS_BYTES) != hipSuccess || per_cu < 1) { fprintf(stderr, "kernel_launch: occupancy query says %d\n", per_cu); per_cu = 1; }
        (void)hipGetLastError();
        grid = cus;
        if (grid != 256) { fprintf(stderr, "kernel_launch: built for a 256-CU device, found %d CUs\n", cus); grid = -1; return; }
    }
    if (grid < 0) return;
    if (hipMemsetAsync((char*)d_ws + WS_BAR, 0, XCD_BAR_WORDS * 4, stream) != hipSuccess) { fprintf(stderr, "kernel_launch: memset of the barrier words failed\n"); return; }
    Args a{};
    for (int i = 0; i < 30; ++i) a.in[i] = (const float*)d_in[i];
    a.out = (float*)d_out; a.ws = (unsigned char*)d_ws;
#if MK_PER_PHASE
    for (int ph = 0; ph < NPH; ++ph) { a.ph_lo = ph; a.ph_hi = ph + 1; hipLaunchKernelGGL(fwd_kernel, dim3(grid), dim3(512), LDS_BYTES, stream, a); }
#else
    a.ph_lo = 0; a.ph_hi = NPH;
    void* args[] = {&a};
    hipError_t e = hipLaunchCooperativeKernel((const void*)fwd_kernel, dim3(grid), dim3(512), args, LDS_BYTES, stream);
    if (e != hipSuccess) fprintf(stderr, "kernel_launch: cooperative launch failed: %s\n", hipGetErrorString(e));
#endif
}
```
